# Optimizing an MI355X kernel written in HIP

```python
import jax, jax.numpy as jnp
from jax import lax
import numpy as np


D_MODEL = 1024
BATCH = 4
SEQ = 4096
DEPTH = 1
DEC_BATCH = 2
DEC_SEQ = 16384
PAST_LEN = 128

HEAD_DIM = 64
HEADS_PER_GROUP = 8
DILATION_GROUPS = ((128, 1), (512, 4), (2048, 16))
N_GROUPS = 3
N_ATT_HEADS = N_GROUPS * HEADS_PER_GROUP
ATT_WIDTH = N_ATT_HEADS * HEAD_DIM
ATT_OUT_WIDTH = HEADS_PER_GROUP * HEAD_DIM
CONV_DIM = D_MODEL
CONV_WIDTH = 3
D_FF = 4 * D_MODEL
ROPE_THETA = 10000.0
EPS = 1e-6
NEG = -1e30
SPLIT_SIZES = (ATT_WIDTH, ATT_WIDTH, ATT_WIDTH, CONV_DIM, CONV_DIM, CONV_DIM, D_MODEL, D_MODEL)
IN_WIDTH = 3 * ATT_WIDTH + 3 * CONV_DIM + 2 * D_MODEL

kernel_name = "hybrid_dilated_attn_shortconv_encoder"


def rms_norm(x, g):
    xf = x.astype(jnp.float32)
    y = xf * lax.rsqrt(jnp.mean(xf * xf, axis=-1, keepdims=True) + EPS)
    return (y * g.astype(jnp.float32)).astype(x.dtype)


def rope(x, pos):
    half = HEAD_DIM // 2
    inv = 1.0 / (ROPE_THETA ** (jnp.arange(half, dtype=jnp.float32) / half))
    ang = pos.astype(jnp.float32)[:, None] * inv[None, :]
    cos = jnp.cos(ang)[None, :, None, :]
    sin = jnp.sin(ang)[None, :, None, :]
    xf = x.astype(jnp.float32)
    x1, x2 = xf[..., :half], xf[..., half:]
    return jnp.concatenate([x1 * cos - x2 * sin, x2 * cos + x1 * sin], axis=-1).astype(x.dtype)


def banded_attention(q, k, v, half):
    n, L, H, hd = q.shape
    blk = half
    nb = -(-L // blk)
    pad = nb * blk - L
    qb = jnp.pad(q, ((0, 0), (0, pad), (0, 0), (0, 0))).reshape(n, nb, blk, H, hd)
    kp = jnp.pad(k, ((0, 0), (blk, pad + blk), (0, 0), (0, 0))).reshape(n, nb + 2, blk, H, hd)
    vp = jnp.pad(v, ((0, 0), (blk, pad + blk), (0, 0), (0, 0))).reshape(n, nb + 2, blk, H, hd)
    kb = jnp.concatenate([kp[:, :-2], kp[:, 1:-1], kp[:, 2:]], axis=2)
    vb = jnp.concatenate([vp[:, :-2], vp[:, 1:-1], vp[:, 2:]], axis=2)
    s = jnp.einsum("nbqhd,nbkhd->nbhqk", qb, kb, preferred_element_type=jnp.float32) * (hd ** -0.5)
    qpos = jnp.arange(nb)[:, None] * blk + jnp.arange(blk)[None, :]
    kpos = jnp.arange(nb)[:, None] * blk - blk + jnp.arange(3 * blk)[None, :]
    rel = kpos[:, None, :] - qpos[:, :, None]
    valid = (jnp.abs(rel) <= half) & (kpos[:, None, :] >= 0) & (kpos[:, None, :] < L)
    s = jnp.where(valid[None, :, None, :, :], s, NEG)
    m = jnp.max(s, axis=-1, keepdims=True)
    p = jnp.exp(s - m)
    den = jnp.sum(p, axis=-1)
    o = jnp.einsum("nbhqk,nbkhd->nbqhd", p.astype(v.dtype), vb, preferred_element_type=jnp.float32)
    den_t = jnp.transpose(den, (0, 1, 3, 2))
    o = o / den_t[..., None]
    lse = jnp.transpose(m[..., 0], (0, 1, 3, 2)) + jnp.log(den_t)
    o = o.reshape(n, nb * blk, H, hd)[:, :L]
    lse = lse.reshape(n, nb * blk, H)[:, :L]
    return o, lse


def dilated_group(q, k, v, window, dil):
    B, S, H, hd = q.shape
    L = S // dil
    half = window // (2 * dil)

    def to_res(t):
        return t.reshape(B, L, dil, H, hd).transpose(0, 2, 1, 3, 4).reshape(B * dil, L, H, hd)

    o, lse = banded_attention(to_res(q), to_res(k), to_res(v), half)
    o = o.reshape(B, dil, L, H, hd).transpose(0, 2, 1, 3, 4).reshape(B, S, H, hd)
    lse = lse.reshape(B, dil, L, H).transpose(0, 2, 1, 3).reshape(B, S, H)
    return o, lse


def token_mixer(xn, w_in, conv_w, conv_b, w_attn_out, w_conv_out, w_mix_out):
    B, S, _ = xn.shape
    proj = jnp.einsum("bsd,de->bse", xn, w_in)
    points = []
    acc = 0
    for sz in SPLIT_SIZES[:-1]:
        acc += sz
        points.append(acc)
    q, k, v, h, c_gate, b_gate, g_att, g_conv = jnp.split(proj, points, axis=-1)
    pos = jnp.arange(S)
    q = rope(q.reshape(B, S, N_ATT_HEADS, HEAD_DIM), pos)
    k = rope(k.reshape(B, S, N_ATT_HEADS, HEAD_DIM), pos)
    v = v.reshape(B, S, N_ATT_HEADS, HEAD_DIM)
    outs = []
    lses = []
    for gi, (window, dil) in enumerate(DILATION_GROUPS):
        lo, hi = gi * HEADS_PER_GROUP, (gi + 1) * HEADS_PER_GROUP
        o, lse = dilated_group(q[:, :, lo:hi], k[:, :, lo:hi], v[:, :, lo:hi], window, dil)
        outs.append(o)
        lses.append(lse)
    wts = jax.nn.softmax(jnp.stack(lses, axis=0), axis=0)
    att = jnp.sum(wts[..., None] * jnp.stack(outs, axis=0), axis=0)
    att = att.astype(xn.dtype).reshape(B, S, ATT_OUT_WIDTH)
    att = jnp.einsum("bse,ed->bsd", att, w_attn_out)
    u = c_gate * h
    r = CONV_WIDTH // 2
    up = jnp.pad(u, ((0, 0), (r, r), (0, 0)))
    conv = conv_b[None, None, :]
    for t in range(CONV_WIDTH):
        conv = conv + up[:, t:t + S] * conv_w[t][None, None, :]
    cv = jnp.einsum("bse,ed->bsd", b_gate * conv, w_conv_out)
    merged = jax.nn.sigmoid(g_att) * att + jax.nn.sigmoid(g_conv) * cv
    return jnp.einsum("bsd,de->bse", merged, w_mix_out)


def encoder(x, c, w_ada, b_ada, norm1_g, w_in, conv_w, conv_b, w_attn_out, w_conv_out,
            w_mix_out, norm2_g, w_mlp_in, w_mlp_out, final_norm_g):
    for l in range(DEPTH):
        mod = jnp.einsum("bd,de->be", jax.nn.silu(c), w_ada[l]) + b_ada[l]
        sh1, sc1, gt1, sh2, sc2, gt2 = jnp.split(mod, 6, axis=-1)
        xn = rms_norm(x, norm1_g[l]) * (1.0 + sc1[:, None, :]) + sh1[:, None, :]
        x = x + gt1[:, None, :] * token_mixer(xn, w_in[l], conv_w[l], conv_b[l], w_attn_out[l],
                                              w_conv_out[l], w_mix_out[l])
        xn = rms_norm(x, norm2_g[l]) * (1.0 + sc2[:, None, :]) + sh2[:, None, :]
        hdn = jnp.square(jax.nn.relu(jnp.einsum("bsd,df->bsf", xn, w_mlp_in[l])))
        x = x + gt2[:, None, :] * jnp.einsum("bsf,fd->bsd", hdn, w_mlp_out[l])
    return rms_norm(x, final_norm_g)


def setup_inputs(seed: int = 0) -> dict:
    key = jax.random.key(seed)
    ks = jax.random.split(key, 20)
    f32 = jnp.float32
    nrm = lambda k, shape, s: jax.random.normal(k, shape, f32) * s
    return {
        "x_prompt": nrm(ks[0], (BATCH, SEQ, D_MODEL), 1.0),
        "x_sample": nrm(ks[1], (DEC_BATCH, DEC_SEQ, D_MODEL), 1.0),
        "c_prompt": nrm(ks[2], (BATCH, D_MODEL), 1.0),
        "c_sample": nrm(ks[3], (DEC_BATCH, D_MODEL), 1.0),
        "w_ada": nrm(ks[4], (DEPTH, D_MODEL, 6 * D_MODEL), 0.5 * D_MODEL ** -0.5),
        "b_ada": nrm(ks[5], (DEPTH, 6 * D_MODEL), 0.02),
        "norm1_g": 1.0 + nrm(ks[6], (DEPTH, D_MODEL), 0.02),
        "w_in": nrm(ks[7], (DEPTH, D_MODEL, IN_WIDTH), D_MODEL ** -0.5),
        "conv_w": nrm(ks[8], (DEPTH, CONV_WIDTH, CONV_DIM), CONV_WIDTH ** -0.5),
        "conv_b": nrm(ks[9], (DEPTH, CONV_DIM), 0.02),
        "w_attn_out": nrm(ks[10], (DEPTH, ATT_OUT_WIDTH, D_MODEL), ATT_OUT_WIDTH ** -0.5),
        "w_conv_out": nrm(ks[11], (DEPTH, CONV_DIM, D_MODEL), CONV_DIM ** -0.5),
        "w_mix_out": nrm(ks[12], (DEPTH, D_MODEL, D_MODEL), D_MODEL ** -0.5),
        "norm2_g": 1.0 + nrm(ks[13], (DEPTH, D_MODEL), 0.02),
        "w_mlp_in": nrm(ks[14], (DEPTH, D_MODEL, D_FF), D_MODEL ** -0.5),
        "w_mlp_out": nrm(ks[15], (DEPTH, D_FF, D_MODEL), D_FF ** -0.5),
        "final_norm_g": 1.0 + nrm(ks[16], (D_MODEL,), 0.02),
    }


def reference(x_prompt, x_sample, c_prompt, c_sample, w_ada, b_ada, norm1_g, w_in, conv_w, conv_b,
              w_attn_out, w_conv_out, w_mix_out, norm2_g, w_mlp_in, w_mlp_out, final_norm_g):
    y_prompt = encoder(x_prompt, c_prompt, w_ada, b_ada, norm1_g, w_in, conv_w, conv_b, w_attn_out,
                       w_conv_out, w_mix_out, norm2_g, w_mlp_in, w_mlp_out, final_norm_g)
    y_sample = encoder(x_sample, c_sample, w_ada, b_ada, norm1_g, w_in, conv_w, conv_b, w_attn_out,
                       w_conv_out, w_mix_out, norm2_g, w_mlp_in, w_mlp_out, final_norm_g)
    return (y_prompt, y_sample)
```

```cpp
#include <hip/hip_runtime.h>
#include <hip/hip_cooperative_groups.h>
#include <cstdio>
#include <cstdint>
namespace cg = cooperative_groups;
namespace pg8 {
#define PG8_LAS __attribute__((address_space(3)))
typedef unsigned short bf16_t;
typedef short bf16x8 __attribute__((ext_vector_type(8)));
typedef float f32x4 __attribute__((ext_vector_type(4)));
typedef unsigned u32x4 __attribute__((ext_vector_type(4)));
constexpr int BM = 256, BK = 64, HALF = 128, HTB = HALF * BK * 2  , STAGE_BYTES = 8 * HTB, NXCD = 8, WGM = 8;

__host__ __device__ __forceinline__ int lds_byte(int r, int c) { const int st = (r >> 4) * 2 + (c >> 5), rr = r & 15, cc = c & 31, ob = rr * 64 + cc * 2; return st * 1024 + (ob ^ (((ob >> 9) & 1) << 5)); }
__host__ __device__ __forceinline__ void stage_rc(int b, int& R, int& C) { const int st = b / 1024, sb = b % 1024, swz = sb ^ (((sb >> 9) & 1) << 5); R = (st >> 1) * 16 + swz / 64; C = (st & 1) * 32 + (swz % 64) / 2; }
__host__ __device__ __forceinline__ int perm32(int rho) { const int n = rho >> 4, i = rho & 15; return 8 * (i >> 2) + 4 * n + (i & 3); }

struct Unit { int pm, pn; };
struct Gemm { const bf16_t* A; const bf16_t* Bt; int M, N, K; };

struct StaticOrder {
    int nM, nN, nwg, G, c;
    __host__ __device__ void init(int M, int N, int G_, int c_) { nM = M / BM; nN = N / BM; nwg = nM * nN; G = G_; c = c_; }
    __host__ __device__ bool next(int i, Unit& u) const {
        const long L = (long)i * G + c; if (L >= nwg) return false;
        int wgid = (int)L; { const int q = nwg / NXCD, r = nwg % NXCD, xcd = wgid % NXCD, off = wgid / NXCD; wgid = (xcd < r ? xcd * (q + 1) : r * (q + 1) + (xcd - r) * q) + off; }
        const int nig = WGM * nN, gid = wgid / nig, fm = gid * WGM, gsz = (nM - fm) < WGM ? (nM - fm) : WGM;
        u.pm = fm + ((wgid % nig) % gsz); u.pn = (wgid % nig) / gsz; return true;
    }
    __device__ __forceinline__ void a_ready(const Unit&) const {}
    __device__ __forceinline__ void done(const Unit&) const {}
};

__device__ __forceinline__ unsigned cvt_pk_bf16(float lo, float hi) { unsigned r; asm volatile("v_cvt_pk_bf16_f32 %0, %1, %2" : "=v"(r) : "v"(lo), "v"(hi)); return r; }
typedef float f32x2 __attribute__((ext_vector_type(2)));
template <class Epi, class Sched, bool ALIGN_EPI = false, bool SP2 = false>
__device__ __forceinline__ void gemm_phase(PG8_LAS unsigned char* lds, const Gemm g, const Sched& S, const Epi& E) {
    int tid_ = threadIdx.x; asm volatile("" : "+v"(tid_));
    const int tid = tid_, wid = __builtin_amdgcn_readfirstlane(tid >> 6), lane = tid & 63, wr = wid >> 2, wc = wid & 3, fr = lane & 15, fq = lane >> 4;
    const int K = g.K, nt = K / BK;
    unsigned voffA[2], voffB[2];
#pragma unroll
    for (int i = 0; i < 2; ++i) { int R, C; stage_rc(tid * 16 + i * 8192, R, C); const int Rb = Epi::PERM ? ((R & ~31) + perm32(R & 31)) : R;
        voffA[i] = (unsigned)(R * K + C) * 2u; voffB[i] = (unsigned)(Rb * K + C) * 2u; }
    const size_t kstep = (size_t)(BK * 2);
    const size_t hstep = (size_t)HALF * K * 2;
    const size_t tstep = 2 * hstep;
    const unsigned ldsw = (unsigned)wid * 1024u;
    const int aoff = lds_byte(wr * 64 + fr, fq * 8), boff = lds_byte(wc * 32 + fr, fq * 8);
#define PG8_SA(b, h) (((b) * 2 + (h)) * HTB)
#define PG8_SB(b, h) ((4 + (b) * 2 + (h)) * HTB)
#define PG8_STAGE(bufoff, gbase, voff) do { _Pragma("unroll") for (int _i = 0; _i < 2; ++_i) \
        __builtin_amdgcn_global_load_lds((const unsigned*)((const char*)(gbase) + (voff)[_i]), (PG8_LAS unsigned*)(lds + (bufoff) + ldsw + _i * 8192), 16, 0, 0); } while (0)
#define PG8_LDA(dst, b, h) do { _Pragma("unroll") for (int m = 0; m < 4; ++m) _Pragma("unroll") for (int k = 0; k < 2; ++k) dst[m][k] = *(const PG8_LAS bf16x8*)(lds + PG8_SA(b, h) + aoff + m * 2048 + k * 1024); } while (0)
#define PG8_LDB(dst, b, h) do { _Pragma("unroll") for (int n = 0; n < 2; ++n) _Pragma("unroll") for (int k = 0; k < 2; ++k) dst[n][k] = *(const PG8_LAS bf16x8*)(lds + PG8_SB(b, h) + boff + n * 2048 + k * 1024); } while (0)
#define PG8_MMA(ai, bj, At, Bt) do { __builtin_amdgcn_s_setprio(1); _Pragma("unroll") for (int m = 0; m < 4; ++m) _Pragma("unroll") for (int n = 0; n < 2; ++n) _Pragma("unroll") for (int k = 0; k < 2; ++k) \
        acc[ai][bj][m][n] = __builtin_amdgcn_mfma_f32_16x16x32_bf16(Bt[n][k], At[m][k], acc[ai][bj][m][n], 0, 0, 0); __builtin_amdgcn_s_setprio(0); } while (0)
#define PG8_WAIT_V(n) asm volatile("s_waitcnt vmcnt(" #n ")" ::: "memory")
#define PG8_WAIT_L(n) asm volatile("s_waitcnt lgkmcnt(" #n ")" ::: "memory")
#define PG8_BAR __builtin_amdgcn_s_barrier()
#define PG8_SCHED __builtin_amdgcn_sched_barrier(0)
    Unit cur, nxt; int ui = 0;
    if (!S.next(0, cur)) return;
    f32x4 acc[2][2][4][2];
#pragma unroll
    for (int a = 0; a < 2; ++a)
#pragma unroll
        for (int b = 0; b < 2; ++b)
#pragma unroll
            for (int m = 0; m < 4; ++m)
#pragma unroll
                for (int n = 0; n < 2; ++n) acc[a][b][m][n] = (f32x4){0.f, 0.f, 0.f, 0.f};
    bf16x8 At[4][2], B0[2][2], B1[2][2];
    const char* cA = (const char*)g.A + (size_t)cur.pm * tstep; const char* cB = (const char*)g.Bt + (size_t)cur.pn * tstep;
    S.a_ready(cur);
    if constexpr (SP2) {
        PG8_STAGE(PG8_SB(0, 0), cB, voffB); PG8_STAGE(PG8_SB(0, 1), cB + hstep, voffB); PG8_STAGE(PG8_SA(0, 0), cA, voffA); PG8_STAGE(PG8_SA(0, 1), cA + hstep, voffA);
        if (wr == 1) PG8_BAR;
        PG8_WAIT_V(2); PG8_BAR;
        PG8_STAGE(PG8_SB(1, 0), cB + kstep, voffB); PG8_STAGE(PG8_SA(1, 0), cA + kstep, voffA); PG8_STAGE(PG8_SB(1, 1), cB + hstep + kstep, voffB);
        PG8_WAIT_V(6); PG8_BAR;
    } else {
        PG8_STAGE(PG8_SB(0, 0), cB, voffB); PG8_STAGE(PG8_SA(0, 0), cA, voffA); PG8_STAGE(PG8_SB(0, 1), cB + hstep, voffB); PG8_STAGE(PG8_SA(0, 1), cA + hstep, voffA);
        if (wr == 1) PG8_BAR;
        PG8_WAIT_V(4); PG8_BAR;
        PG8_STAGE(PG8_SB(1, 0), cB + kstep, voffB); PG8_STAGE(PG8_SA(1, 0), cA + kstep, voffA); PG8_STAGE(PG8_SB(1, 1), cB + hstep + kstep, voffB);
        PG8_WAIT_V(6); PG8_BAR;
    }
    for (;;) {
        const bool has_next = S.next(ui + 1, nxt);
        const char* nA = has_next ? (const char*)g.A + (size_t)nxt.pm * tstep : cA; const char* nB = has_next ? (const char*)g.Bt + (size_t)nxt.pn * tstep : cB;
        for (int t = 0; t < nt; t += 2) {
            const bool last = (t == nt - 2);
            const char* a1 = cA + (size_t)(t + 1) * kstep;
            const char* a2 = last ? nA : cA + (size_t)(t + 2) * kstep; const char* b2 = last ? nB : cB + (size_t)(t + 2) * kstep;
            const char* a3 = a2 + kstep; const char* b3 = b2 + kstep;
            if (last && has_next) S.a_ready(nxt);
            if constexpr (SP2) {
            PG8_LDB(B0, 0, 0); PG8_LDB(B1, 0, 1); PG8_SCHED; PG8_LDA(At, 0, 0); PG8_STAGE(PG8_SA(1, 1), a1 + hstep, voffA);
            PG8_WAIT_V(8); PG8_WAIT_L(0); PG8_BAR; PG8_MMA(0, 0, At, B0); PG8_MMA(0, 1, At, B1); PG8_BAR; PG8_SCHED;
            PG8_LDA(At, 0, 1); PG8_STAGE(PG8_SB(0, 0), b2, voffB); PG8_STAGE(PG8_SB(0, 1), b2 + hstep, voffB); PG8_STAGE(PG8_SA(0, 0), a2, voffA);
            PG8_WAIT_V(8); PG8_WAIT_L(0); PG8_BAR; PG8_MMA(1, 0, At, B0); PG8_MMA(1, 1, At, B1); PG8_BAR; PG8_SCHED;
            PG8_LDB(B0, 1, 0); PG8_LDB(B1, 1, 1); PG8_SCHED; PG8_LDA(At, 1, 0); PG8_STAGE(PG8_SA(0, 1), a2 + hstep, voffA);
            PG8_WAIT_V(8); PG8_WAIT_L(0); PG8_BAR; PG8_MMA(0, 0, At, B0); PG8_MMA(0, 1, At, B1); PG8_BAR; PG8_SCHED;
            PG8_LDA(At, 1, 1); PG8_STAGE(PG8_SB(1, 0), b3, voffB); PG8_STAGE(PG8_SB(1, 1), b3 + hstep, voffB); PG8_STAGE(PG8_SA(1, 0), a3, voffA);
            PG8_WAIT_V(8); PG8_WAIT_L(0); PG8_BAR; PG8_MMA(1, 0, At, B0); PG8_MMA(1, 1, At, B1); PG8_BAR; PG8_SCHED;
            } else {
            PG8_LDB(B0, 0, 0); PG8_SCHED; PG8_LDA(At, 0, 0); PG8_STAGE(PG8_SA(1, 1), a1 + hstep, voffA);
            PG8_WAIT_L(8); PG8_BAR; PG8_WAIT_L(0); PG8_MMA(0, 0, At, B0); PG8_BAR; PG8_SCHED;
            PG8_LDB(B1, 0, 1); PG8_STAGE(PG8_SB(0, 0), b2, voffB);
            PG8_BAR; PG8_WAIT_L(0); PG8_MMA(0, 1, At, B1); PG8_BAR;
            PG8_LDA(At, 0, 1); PG8_STAGE(PG8_SA(0, 0), a2, voffA);
            PG8_BAR; PG8_WAIT_L(0); PG8_MMA(1, 0, At, B0); PG8_BAR; PG8_SCHED;
            PG8_STAGE(PG8_SB(0, 1), b2 + hstep, voffB);
            PG8_WAIT_V(6); PG8_BAR; PG8_MMA(1, 1, At, B1); PG8_BAR;
            PG8_LDB(B0, 1, 0); PG8_SCHED; PG8_LDA(At, 1, 0); PG8_STAGE(PG8_SA(0, 1), a2 + hstep, voffA);
            PG8_WAIT_L(8); PG8_BAR; PG8_WAIT_L(0); PG8_MMA(0, 0, At, B0); PG8_BAR; PG8_SCHED;
            PG8_LDB(B1, 1, 1); PG8_STAGE(PG8_SB(1, 0), b3, voffB);
            PG8_BAR; PG8_WAIT_L(0); PG8_MMA(0, 1, At, B1); PG8_BAR;
            PG8_LDA(At, 1, 1); PG8_STAGE(PG8_SA(1, 0), a3, voffA);
            PG8_BAR; PG8_WAIT_L(0); PG8_MMA(1, 0, At, B0); PG8_BAR; PG8_SCHED;
            PG8_STAGE(PG8_SB(1, 1), b3 + hstep, voffB);
            PG8_WAIT_V(6); PG8_BAR; PG8_MMA(1, 1, At, B1); PG8_BAR;
            }
        }
        if constexpr (ALIGN_EPI) { if (wr == 0) PG8_BAR; }
        if constexpr (!Epi::AFTER_DRAIN) { E(acc, cur, wr, wc, fr, fq); S.done(cur); }
        if (!has_next) break;
#pragma unroll
        for (int a = 0; a < 2; ++a)
#pragma unroll
            for (int b = 0; b < 2; ++b)
#pragma unroll
                for (int m = 0; m < 4; ++m)
#pragma unroll
                    for (int n = 0; n < 2; ++n) acc[a][b][m][n] = (f32x4){0.f, 0.f, 0.f, 0.f};
        cur = nxt; cA = nA; cB = nB; ++ui;
        if constexpr (ALIGN_EPI) { if (wr == 1) PG8_BAR; }
    }
    PG8_WAIT_V(0);
    if constexpr (!ALIGN_EPI) { if (wr == 0) PG8_BAR; }
    PG8_BAR;
    if constexpr (Epi::AFTER_DRAIN) { E.fused(acc, cur, wr, wc, fr, fq, lds, wid, lane); S.done(cur); }
#undef PG8_SA
#undef PG8_SB
#undef PG8_STAGE
#undef PG8_LDA
#undef PG8_LDB
#undef PG8_MMA
#undef PG8_WAIT_V
#undef PG8_WAIT_L
#undef PG8_BAR
#undef PG8_SCHED
}
}

#define GAS __attribute__((address_space(1)))
#define LAS __attribute__((address_space(3)))
typedef unsigned short bf16;
typedef unsigned v4u __attribute__((ext_vector_type(4)));
typedef unsigned v2u __attribute__((ext_vector_type(2)));
typedef float f32x4 __attribute__((ext_vector_type(4)));
constexpr int DM = 1024, MTOT = 49152, MC = 16384, NCHUNK = 3, NB = 6;
constexpr int NIN = 9728, DFF = 4096, QW = 1536, ATTO = 512;
constexpr float EPS = 1e-6f;
constexpr float QSCALE = 0.125f * 1.4426950408889634f;
constexpr int NWAVES = 8;
constexpr size_t MiB = 1u << 20;
constexpr size_t WS_MOD = 1 * MiB, WS_ROPE = 2 * MiB, WS_WIN = 6 * MiB, WS_WAO = 25 * MiB, WS_WCO = 26 * MiB, WS_WMO = 28 * MiB, WS_WMI = 30 * MiB, WS_WMO2 = 38 * MiB;
constexpr size_t WS_Q = 48 * MiB, WS_K = 96 * MiB, WS_V = 144 * MiB, WS_U = 192 * MiB, WS_BG = 224 * MiB, WS_GA = 256 * MiB, WS_GC = 288 * MiB;
constexpr size_t WS_ATT = 320 * MiB, WS_CVIN = 336 * MiB, WS_T1 = 368 * MiB, WS_MRG = 400 * MiB, WS_XN2 = 432 * MiB, WS_END = 464 * MiB;
constexpr size_t WS_HDN = 48 * MiB;
constexpr int LDS_BYTES = 147456;

__device__ __forceinline__ unsigned pkbf(float lo, float hi) { unsigned r; asm volatile("v_cvt_pk_bf16_f32 %0, %1, %2" : "=v"(r) : "v"(lo), "v"(hi)); return r; }
__device__ __forceinline__ float bflo(unsigned u) { return __builtin_bit_cast(float, u << 16); }
__device__ __forceinline__ float bfhi(unsigned u) { return __builtin_bit_cast(float, u & 0xffff0000u); }
__device__ __forceinline__ float wave_sum(float v) {
#pragma unroll
    for (int o = 1; o < 64; o <<= 1) v += __shfl_xor(v, o);
    return v;
}
__device__ __forceinline__ float wave_max(float v) {
#pragma unroll
    for (int o = 1; o < 64; o <<= 1) v = fmaxf(v, __shfl_xor(v, o));
    return v;
}
__device__ __forceinline__ float sigmoidf_(float x) { return __builtin_amdgcn_rcpf(1.f + __expf(-x)); }
__device__ __forceinline__ void rowinfo(int chunk, int r, int& bi, int& s, int& S) { if (chunk == 0) { bi = r >> 12; s = r & 4095; S = 4096; } else { bi = 3 + chunk; s = r; S = 16384; } }

namespace pg8 {
struct EpiIn {
    static constexpr bool PERM = true, AFTER_DRAIN = false;
    int chunk; unsigned char* ws;
    __device__ __forceinline__ void operator()(const f32x4 (&acc)[2][2][4][2], const Unit& u, int wr, int wc, int fr, int fq) const {
        const int pn = u.pn; const int row0 = u.pm * BM + wr * 64 + fr;
        bf16_t* const Q = (bf16_t*)(ws + WS_Q); bf16_t* const K = (bf16_t*)(ws + WS_K); bf16_t* const V = (bf16_t*)(ws + WS_V); bf16_t* const U = (bf16_t*)(ws + WS_U);
        bf16_t* const BG = (bf16_t*)(ws + WS_BG); bf16_t* const GA = (bf16_t*)(ws + WS_GA); bf16_t* const GC = (bf16_t*)(ws + WS_GC); const float* const rope = (const float*)(ws + WS_ROPE);
        if (pn < 12) {
            bf16_t* base = (pn < 6) ? Q : K; const int hd = 4 * (pn < 6 ? pn : pn - 6) + wc; const float sc = (pn < 6) ? QSCALE : 1.f;
#pragma unroll
            for (int ai = 0; ai < 2; ++ai)
#pragma unroll
                for (int m = 0; m < 4; ++m) {
                    const int row = row0 + ai * HALF + m * 16; const int s = (chunk == 0) ? (row & 4095) : row;
                    const f32x4* rp = (const f32x4*)(rope + (size_t)s * 64 + 16 * fq);
                    const f32x4 c0 = rp[0], c1 = rp[1], c2 = rp[2], c3 = rp[3];
                    const f32x4 a0 = acc[ai][0][m][0], a1 = acc[ai][0][m][1], b0 = acc[ai][1][m][0], b1 = acc[ai][1][m][1];
                    u32x4 w1, w2;
                    w1.x = cvt_pk_bf16((a0[0] * c0[0] - b0[0] * c0[1]) * sc, (a0[1] * c0[2] - b0[1] * c0[3]) * sc);
                    w1.y = cvt_pk_bf16((a0[2] * c1[0] - b0[2] * c1[1]) * sc, (a0[3] * c1[2] - b0[3] * c1[3]) * sc);
                    w1.z = cvt_pk_bf16((a1[0] * c2[0] - b1[0] * c2[1]) * sc, (a1[1] * c2[2] - b1[1] * c2[3]) * sc);
                    w1.w = cvt_pk_bf16((a1[2] * c3[0] - b1[2] * c3[1]) * sc, (a1[3] * c3[2] - b1[3] * c3[3]) * sc);
                    w2.x = cvt_pk_bf16((b0[0] * c0[0] + a0[0] * c0[1]) * sc, (b0[1] * c0[2] + a0[1] * c0[3]) * sc);
                    w2.y = cvt_pk_bf16((b0[2] * c1[0] + a0[2] * c1[1]) * sc, (b0[3] * c1[2] + a0[3] * c1[3]) * sc);
                    w2.z = cvt_pk_bf16((b1[0] * c2[0] + a1[0] * c2[1]) * sc, (b1[1] * c2[2] + a1[1] * c2[3]) * sc);
                    w2.w = cvt_pk_bf16((b1[2] * c3[0] + a1[2] * c3[1]) * sc, (b1[3] * c3[2] + a1[3] * c3[3]) * sc);
                    bf16_t* p = base + (size_t)row * 1536 + hd * 64 + 8 * fq;
                    *(u32x4*)p = w1; *(u32x4*)(p + 32) = w2;
                }
        } else if (pn < 18) {
#pragma unroll
            for (int ai = 0; ai < 2; ++ai)
#pragma unroll
                for (int m = 0; m < 4; ++m)
#pragma unroll
                    for (int bj = 0; bj < 2; ++bj) {
                        const int row = row0 + ai * HALF + m * 16; const f32x4 v0 = acc[ai][bj][m][0], v1 = acc[ai][bj][m][1];
                        u32x4 w; w.x = cvt_pk_bf16(v0[0], v0[1]); w.y = cvt_pk_bf16(v0[2], v0[3]); w.z = cvt_pk_bf16(v1[0], v1[1]); w.w = cvt_pk_bf16(v1[2], v1[3]);
                        *(u32x4*)(V + (size_t)row * 1536 + (pn - 12) * 256 + bj * HALF + wc * 32 + 8 * fq) = w;
                    }
        } else if (pn < 26) {
#pragma unroll
            for (int ai = 0; ai < 2; ++ai)
#pragma unroll
                for (int m = 0; m < 4; ++m) {
                    const int row = row0 + ai * HALF + m * 16; const f32x4 v0 = acc[ai][0][m][0] * acc[ai][1][m][0], v1 = acc[ai][0][m][1] * acc[ai][1][m][1];
                    u32x4 w; w.x = cvt_pk_bf16(v0[0], v0[1]); w.y = cvt_pk_bf16(v0[2], v0[3]); w.z = cvt_pk_bf16(v1[0], v1[1]); w.w = cvt_pk_bf16(v1[2], v1[3]);
                    *(u32x4*)(U + (size_t)row * 1024 + (pn - 18) * 128 + wc * 32 + 8 * fq) = w;
                }
        } else {
            bf16_t* base = (pn < 30) ? BG : (pn < 34) ? GA : GC; const int ct = (pn < 30) ? pn - 26 : (pn < 34) ? pn - 30 : pn - 34; const bool sg = pn >= 30;
#pragma unroll
            for (int ai = 0; ai < 2; ++ai)
#pragma unroll
                for (int m = 0; m < 4; ++m)
#pragma unroll
                    for (int bj = 0; bj < 2; ++bj) {
                        const int row = row0 + ai * HALF + m * 16; f32x4 v0 = acc[ai][bj][m][0], v1 = acc[ai][bj][m][1];
                        if (sg) {
#pragma unroll
                            for (int e = 0; e < 4; ++e) { v0[e] = sigmoidf_(v0[e]); v1[e] = sigmoidf_(v1[e]); } }
                        u32x4 w; w.x = cvt_pk_bf16(v0[0], v0[1]); w.y = cvt_pk_bf16(v0[2], v0[3]); w.z = cvt_pk_bf16(v1[0], v1[1]); w.w = cvt_pk_bf16(v1[2], v1[3]);
                        *(u32x4*)(base + (size_t)row * 1024 + ct * 256 + bj * HALF + wc * 32 + 8 * fq) = w;
                    }
        }
    }
};
template <int MODE> struct EpiGate {
    static constexpr bool PERM = true, AFTER_DRAIN = false;
    bf16_t* O; const bf16_t* G; const bf16_t* ADD; int ldc;
    __device__ __forceinline__ void operator()(const f32x4 (&acc)[2][2][4][2], const Unit& u, int wr, int wc, int fr, int fq) const {
        const int row0 = u.pm * BM + wr * 64 + fr, col0 = u.pn * BM + wc * 32 + 8 * fq;
#pragma unroll
        for (int ai = 0; ai < 2; ++ai)
#pragma unroll
            for (int m = 0; m < 4; ++m)
#pragma unroll
                for (int bj = 0; bj < 2; ++bj) {
                    const size_t idx = (size_t)(row0 + ai * HALF + m * 16) * ldc + col0 + bj * HALF;
                    f32x4 v0 = acc[ai][bj][m][0], v1 = acc[ai][bj][m][1];
                    if (MODE == 2) {
#pragma unroll
                        for (int e = 0; e < 4; ++e) { const float a = fmaxf(v0[e], 0.f), b = fmaxf(v1[e], 0.f); v0[e] = a * a; v1[e] = b * b; }
                    } else {
                        const u32x4 g = *(const u32x4*)(G + idx);
                        v0[0] *= bflo(g.x); v0[1] *= bfhi(g.x); v0[2] *= bflo(g.y); v0[3] *= bfhi(g.y); v1[0] *= bflo(g.z); v1[1] *= bfhi(g.z); v1[2] *= bflo(g.w); v1[3] *= bfhi(g.w);
                        if (MODE == 1) { const u32x4 t = *(const u32x4*)(ADD + idx);
                            v0[0] += bflo(t.x); v0[1] += bfhi(t.x); v0[2] += bflo(t.y); v0[3] += bfhi(t.y); v1[0] += bflo(t.z); v1[1] += bfhi(t.z); v1[2] += bflo(t.w); v1[3] += bfhi(t.w); }
                    }
                    u32x4 w; w.x = cvt_pk_bf16(v0[0], v0[1]); w.y = cvt_pk_bf16(v0[2], v0[3]); w.z = cvt_pk_bf16(v1[0], v1[1]); w.w = cvt_pk_bf16(v1[2], v1[3]);
                    *(u32x4*)(O + idx) = w;
                }
    }
};
struct EpiRes {
    static constexpr bool PERM = false, AFTER_DRAIN = false;
    const float* base; float* out; const float* gt0; int chunk;
    __device__ __forceinline__ void operator()(const f32x4 (&acc)[2][2][4][2], const Unit& u, int wr, int wc, int fr, int fq) const {
        const int row0 = u.pm * BM + wr * 64 + fr, col0 = u.pn * BM + wc * 32 + 4 * fq;
        const int bi = (chunk == 0) ? ((u.pm * BM) >> 12) : 3 + chunk;
        const float* gt = gt0 + bi * 6144;
#pragma unroll
        for (int bj = 0; bj < 2; ++bj)
#pragma unroll
            for (int n = 0; n < 2; ++n) {
                const int col = col0 + bj * HALF + n * 16; const f32x4 g = *(const f32x4*)(gt + col);
#pragma unroll
                for (int ai = 0; ai < 2; ++ai)
#pragma unroll
                    for (int m = 0; m < 4; ++m) { const size_t idx = (size_t)(row0 + ai * HALF + m * 16) * 1024 + col;
                        const f32x4 b = *(const f32x4*)(base + idx); *(f32x4*)(out + idx) = b + g * acc[ai][bj][m][n]; }
            }
    }
};
}

struct Args { const float* in[17]; float* out; unsigned char* ws; int ph_lo, ph_hi; };

__device__ __forceinline__ int win_dst_row(int n0) {
    if (n0 < 3072) { const int tile = n0 >> 8, sb = (n0 >> 5) & 7, hd = sb >> 1, half = sb & 1; return (tile << 8) + ((4 * half + hd) << 5); }
    if (n0 < 4608) return n0;
    if (n0 < 5632) { const int o = n0 - 4608; return (18 + (o >> 7)) * 256 + (o & 127); }
    if (n0 < 6656) { const int o = n0 - 5632; return (18 + (o >> 7)) * 256 + 128 + (o & 127); }
    return n0;
}
__device__ __forceinline__ void p0_transpose_item(const float* W, int K, int N, bf16* WT, bool remap, LAS float* scr, int item, int lane) {
    const int nblk = N / 32, kb = item / nblk, nb = item % nblk, k0 = 64 * kb, n0 = 32 * nb;
    const int d0 = remap ? win_dst_row(n0) : n0;
#pragma unroll 8
    for (int i = 0; i < 32; ++i) { const int kk = 2 * i + (lane >> 5); scr[kk * 33 + (lane & 31)] = W[(size_t)(k0 + kk) * N + n0 + (lane & 31)]; }
    asm volatile("s_waitcnt lgkmcnt(0)" ::: "memory");
    const int c = lane & 7;
#pragma unroll
    for (int j = 0; j < 4; ++j) { const int n = (lane >> 3) + 8 * j; const LAS float* s = scr + (8 * c) * 33 + n;
        v4u o; o.x = pkbf(s[0 * 33], s[1 * 33]); o.y = pkbf(s[2 * 33], s[3 * 33]); o.z = pkbf(s[4 * 33], s[5 * 33]); o.w = pkbf(s[6 * 33], s[7 * 33]);
        *(v4u*)(WT + (size_t)(d0 + n) * K + k0 + 8 * c) = o; }
    asm volatile("s_waitcnt lgkmcnt(0)" ::: "memory");
}
__device__ __forceinline__ void norm_row_bf16(const float* xrow, bf16* orow, const float* g, const float* sc, const float* sh, int lane) {
    const f32x4* xr = (const f32x4*)xrow + lane; f32x4 v[4]; float s = 0.f;
#pragma unroll
    for (int j = 0; j < 4; ++j) { v[j] = xr[64 * j]; s += (v[j].x * v[j].x + v[j].y * v[j].y) + (v[j].z * v[j].z + v[j].w * v[j].w); }
    const float rstd = 1.f / sqrtf(wave_sum(s) * (1.f / 1024.f) + EPS);
    unsigned long long* o8 = (unsigned long long*)orow + lane;
#pragma unroll
    for (int j = 0; j < 4; ++j) {
        const f32x4 gg = ((const f32x4*)g)[lane + 64 * j], cc = ((const f32x4*)sc)[lane + 64 * j], hh = ((const f32x4*)sh)[lane + 64 * j];
        const f32x4 y = v[j] * rstd * gg * (cc + 1.0f) + hh;
        o8[64 * j] = (unsigned long long)pkbf(y.x, y.y) | ((unsigned long long)pkbf(y.z, y.w) << 32);
    }
}
__device__ __forceinline__ void norm_row_f32(float* xrow, const float* g, int lane) {
    f32x4* xr = (f32x4*)xrow + lane; f32x4 v[4]; float s = 0.f;
#pragma unroll
    for (int j = 0; j < 4; ++j) { v[j] = xr[64 * j]; s += (v[j].x * v[j].x + v[j].y * v[j].y) + (v[j].z * v[j].z + v[j].w * v[j].w); }
    const float rstd = 1.f / sqrtf(wave_sum(s) * (1.f / 1024.f) + EPS);
#pragma unroll
    for (int j = 0; j < 4; ++j) { const f32x4 gg = ((const f32x4*)g)[lane + 64 * j]; xr[64 * j] = v[j] * rstd * gg; }
}

__device__ __forceinline__ float dot64(const v4u* qp, const v4u* kp) {
    float d = 0.f;
#pragma unroll
    for (int c = 0; c < 8; ++c) { const v4u q = qp[c], k = kp[c];
        d += bflo(q.x) * bflo(k.x) + bfhi(q.x) * bfhi(k.x) + bflo(q.y) * bflo(k.y) + bfhi(q.y) * bfhi(k.y)
           + bflo(q.z) * bflo(k.z) + bfhi(q.z) * bfhi(k.z) + bflo(q.w) * bflo(k.w) + bfhi(q.w) * bfhi(k.w); }
    return d;
}
__device__ __forceinline__ void attn_naive_item(const bf16* Q, const bf16* K, const bf16* V, bf16* ATT, int chunk, int r, int hh, int lane) {
    int bi, s, S; rowinfo(chunk, r, bi, s, S); (void)bi;
    float sc[3][3];
#pragma unroll
    for (int g = 0; g < 3; ++g) {
        const int dil = 1 << (2 * g), head = 8 * g + hh;
        const v4u* qp = (const v4u*)(Q + (size_t)r * QW + head * 64);
#pragma unroll
        for (int i = 0; i < 3; ++i) {
            const int jj = lane + 64 * i; const int off = (jj - 64) * dil; const int p = s + off;
            const bool valid = (jj <= 128) && (p >= 0) && (p < S);
            float d = -INFINITY;
            if (valid) d = dot64(qp, (const v4u*)(K + (size_t)(r + off) * QW + head * 64));
            sc[g][i] = d;
        }
    }
    float mx = -INFINITY;
#pragma unroll
    for (int g = 0; g < 3; ++g)
#pragma unroll
        for (int i = 0; i < 3; ++i) mx = fmaxf(mx, sc[g][i]);
    mx = wave_max(mx);
    float sum = 0.f;
#pragma unroll
    for (int g = 0; g < 3; ++g)
#pragma unroll
        for (int i = 0; i < 3; ++i) { sc[g][i] = exp2f(sc[g][i] - mx); sum += sc[g][i]; }
    sum = wave_sum(sum);
    float acc = 0.f;
#pragma unroll
    for (int g = 0; g < 3; ++g) {
        const int dil = 1 << (2 * g), head = 8 * g + hh;
        const bf16* vb = V + (size_t)r * QW + head * 64 + lane;
#pragma unroll
        for (int i = 0; i < 3; ++i) {
            const int nj = (i < 2) ? 64 : 1;
            for (int j = 0; j < nj; ++j) {
                const int off = (64 * i + j - 64) * dil; const int p = s + off;
                if (p < 0 || p >= S) continue;
                const float pj = __builtin_bit_cast(float, __builtin_amdgcn_readlane(__builtin_bit_cast(int, sc[g][i]), j));
                acc += pj * __builtin_bit_cast(float, (unsigned)vb[(long)off * QW] << 16);
            }
        }
    }
    const float o = acc / sum;
    const unsigned ob = pkbf(o, o);
    ATT[(size_t)r * ATTO + hh * 64 + lane] = (bf16)(ob & 0xffffu);
}

constexpr int NPHASE = 2 + 8 * NCHUNK + 1;
typedef __attribute__((address_space(4))) const unsigned char kconst_t;
__device__ __forceinline__ const float* inptr(int i) { kconst_t* kp = (kconst_t*)__builtin_amdgcn_kernarg_segment_ptr(); asm volatile("" : "+s"(kp)); return *(const float* const __attribute__((address_space(4)))*)(kp + 8 * i); }
__device__ __forceinline__ int opq(int v) { asm volatile("" : "+s"(v)); return v; }
__device__ __forceinline__ unsigned char* wsptr() { kconst_t* kp = (kconst_t*)__builtin_amdgcn_kernarg_segment_ptr(); asm volatile("" : "+s"(kp)); return *(unsigned char* const __attribute__((address_space(4)))*)(kp + 8 * 18); }
__device__ __forceinline__ float* outptr() { kconst_t* kp = (kconst_t*)__builtin_amdgcn_kernarg_segment_ptr(); asm volatile("" : "+s"(kp)); return *(float* const __attribute__((address_space(4)))*)(kp + 8 * 17); }
__global__ void __launch_bounds__(NWAVES * 64, 2) mk_fwd(Args args) {
    extern __shared__ __attribute__((aligned(16))) unsigned char lds[];
    cg::grid_group grid = cg::this_grid();
    LAS unsigned char* L = (LAS unsigned char*)lds;
    const int tid = threadIdx.x, lane = tid & 63, wave = __builtin_amdgcn_readfirstlane(tid >> 6);
    const int G = gridDim.x, bx = blockIdx.x;
    const int gw = bx * NWAVES + wave, NGW = G * NWAVES;
    const int lo = args.ph_lo, hi = args.ph_hi;
#define IN(k) (lo <= (k) && (k) < hi)
#define SEAM(k) do { if (IN(k) && IN((k) + 1)) grid.sync(); } while (0)

    if (IN(0)) {
        unsigned char* ws = wsptr();
        LAS float* scr = (LAS float*)(L + wave * 16384);
        constexpr int I_IN = 16 * (NIN / 32), I_AO = 8 * 32, I_CO = 16 * 32, I_MO = 16 * 32, I_MI = 16 * 128, I_MO2 = 64 * 32;
        constexpr int NITEMS = I_IN + I_AO + I_CO + I_MO + I_MI + I_MO2;
        for (int it = gw; it < NITEMS; it += NGW) {
            int r = it;
            if (r < I_IN) { p0_transpose_item(inptr(7), 1024, NIN, (bf16*)(ws + WS_WIN), true, scr, r, lane); continue; } r -= I_IN;
            if (r < I_AO) { p0_transpose_item(inptr(10), 512, 1024, (bf16*)(ws + WS_WAO), false, scr, r, lane); continue; } r -= I_AO;
            if (r < I_CO) { p0_transpose_item(inptr(11), 1024, 1024, (bf16*)(ws + WS_WCO), false, scr, r, lane); continue; } r -= I_CO;
            if (r < I_MO) { p0_transpose_item(inptr(12), 1024, 1024, (bf16*)(ws + WS_WMO), false, scr, r, lane); continue; } r -= I_MO;
            if (r < I_MI) { p0_transpose_item(inptr(14), 1024, 4096, (bf16*)(ws + WS_WMI), false, scr, r, lane); continue; } r -= I_MI;
            p0_transpose_item(inptr(15), 4096, 1024, (bf16*)(ws + WS_WMO2), false, scr, r, lane);
        }
        float* rope = (float*)(ws + WS_ROPE);
        for (int i = bx * 512 + tid; i < 16384 * 32; i += G * 512) {
            const int s = i >> 5, j = i & 31;
            const double inv = exp(-(double)j * (9.210340371976184 / 32.0));
            const double rev = (double)s * inv * 0.15915494309189535;
            const float fr = (float)(rev - rint(rev));
            float2 cs; cs.x = __builtin_amdgcn_cosf(fr); cs.y = __builtin_amdgcn_sinf(fr);
            ((float2*)rope)[i] = cs;
        }
        __syncthreads();
        LAS float* red = (LAS float*)L;
        const float *c_p = inptr(2), *c_s = inptr(3), *w_ada = inptr(4), *b_ada = inptr(5); float* mod = (float*)(ws + WS_MOD);
        for (int item = bx; item < 96; item += G) {
            const int e = item * 64 + lane; float a[NB];
#pragma unroll
            for (int b = 0; b < NB; ++b) a[b] = 0.f;
#pragma unroll 4
            for (int k = 128 * wave; k < 128 * wave + 128; ++k) {
                const float wv = w_ada[(size_t)k * 6144 + e];
#pragma unroll
                for (int b = 0; b < NB; ++b) { const float cv = (b < 4) ? c_p[b * 1024 + k] : c_s[(b - 4) * 1024 + k]; a[b] += (cv * sigmoidf_(cv)) * wv; }
            }
#pragma unroll
            for (int b = 0; b < NB; ++b) red[(wave * NB + b) * 64 + lane] = a[b];
            __syncthreads();
            if (wave < NB) { float t = b_ada[e];
#pragma unroll
                for (int w = 0; w < 8; ++w) t += red[(w * NB + wave) * 64 + lane];
                mod[wave * 6144 + e] = t; }
            __syncthreads();
        }
    }
    SEAM(0);
    if (IN(1)) {
        unsigned char* ws = wsptr(); float* out = outptr(); const float* mod = (const float*)(ws + WS_MOD);
        const float *x0 = inptr(0), *x1 = inptr(1), *g1 = inptr(6);
        for (int m = gw; m < MTOT; m += NGW) {
            const int chunk = m >> 14, r = m & (MC - 1); int bi, s, S; rowinfo(chunk, r, bi, s, S);
            const float* xrow = (m < MC) ? x0 + (size_t)m * DM : x1 + (size_t)(m - MC) * DM;
            bf16* xn = (bf16*)(out + (size_t)chunk * MC * DM) + (size_t)r * DM;
            norm_row_bf16(xrow, xn, g1, mod + bi * 6144 + 1024, mod + bi * 6144, lane);
        }
    }
    SEAM(1);
#pragma nounroll
    for (int chunk = 0; chunk < NCHUNK; ++chunk) {
        const int pb = 2 + 8 * chunk;
        if (IN(pb + 0)) {
            unsigned char* ws = wsptr(); float* outc = outptr() + (size_t)chunk * MC * DM;
            pg8::Gemm g{(const pg8::bf16_t*)outc, (const bf16*)(ws + WS_WIN), MC, NIN, DM}; pg8::StaticOrder S; S.init(MC, NIN, opq(G), opq(bx));
            pg8::EpiIn E{chunk, ws};
            pg8::gemm_phase<pg8::EpiIn, pg8::StaticOrder, true, true>(L, g, S, E);
        }
        SEAM(pb + 0);
        if (IN(pb + 1)) {
            unsigned char* ws = wsptr(); int tid_o = tid, lane_o = lane, gw_o = gw; asm volatile("" : "+v"(tid_o), "+v"(lane_o), "+s"(gw_o));
            const bf16 *Ub = (const bf16*)(ws + WS_U), *BGb = (const bf16*)(ws + WS_BG); bf16* CVb = (bf16*)(ws + WS_CVIN);
            const float *conv_w = inptr(8), *conv_b = inptr(9);
            for (int i = bx * 512 + tid_o; i < MC * 128; i += G * 512) {
                const int r = i >> 7, c8 = (i & 127) * 8; int bi, s, S; rowinfo(chunk, r, bi, s, S);
                const v4u uc = *(const v4u*)(Ub + (size_t)r * 1024 + c8);
                v4u up = {0u, 0u, 0u, 0u}, un = {0u, 0u, 0u, 0u};
                if (s > 0) up = *(const v4u*)(Ub + (size_t)(r - 1) * 1024 + c8);
                if (s < S - 1) un = *(const v4u*)(Ub + (size_t)(r + 1) * 1024 + c8);
                const v4u bg = *(const v4u*)(BGb + (size_t)r * 1024 + c8);
                const f32x4 w0a = *(const f32x4*)(conv_w + c8), w0b = *(const f32x4*)(conv_w + c8 + 4);
                const f32x4 w1a = *(const f32x4*)(conv_w + 1024 + c8), w1b = *(const f32x4*)(conv_w + 1024 + c8 + 4);
                const f32x4 w2a = *(const f32x4*)(conv_w + 2048 + c8), w2b = *(const f32x4*)(conv_w + 2048 + c8 + 4);
                const f32x4 cba = *(const f32x4*)(conv_b + c8), cbb = *(const f32x4*)(conv_b + c8 + 4);
                float y[8];
#define CV1(e, UP, UC, UN, BGV, W0, W1, W2, CB) y[e] = (BGV) * ((CB) + (UP) * (W0) + (UC) * (W1) + (UN) * (W2))
                CV1(0, bflo(up.x), bflo(uc.x), bflo(un.x), bflo(bg.x), w0a[0], w1a[0], w2a[0], cba[0]);
                CV1(1, bfhi(up.x), bfhi(uc.x), bfhi(un.x), bfhi(bg.x), w0a[1], w1a[1], w2a[1], cba[1]);
                CV1(2, bflo(up.y), bflo(uc.y), bflo(un.y), bflo(bg.y), w0a[2], w1a[2], w2a[2], cba[2]);
                CV1(3, bfhi(up.y), bfhi(uc.y), bfhi(un.y), bfhi(bg.y), w0a[3], w1a[3], w2a[3], cba[3]);
                CV1(4, bflo(up.z), bflo(uc.z), bflo(un.z), bflo(bg.z), w0b[0], w1b[0], w2b[0], cbb[0]);
                CV1(5, bfhi(up.z), bfhi(uc.z), bfhi(un.z), bfhi(bg.z), w0b[1], w1b[1], w2b[1], cbb[1]);
                CV1(6, bflo(up.w), bflo(uc.w), bflo(un.w), bflo(bg.w), w0b[2], w1b[2], w2b[2], cbb[2]);
                CV1(7, bfhi(up.w), bfhi(uc.w), bfhi(un.w), bfhi(bg.w), w0b[3], w1b[3], w2b[3], cbb[3]);
#undef CV1
                v4u o; o.x = pkbf(y[0], y[1]); o.y = pkbf(y[2], y[3]); o.z = pkbf(y[4], y[5]); o.w = pkbf(y[6], y[7]);
                *(v4u*)(CVb + (size_t)r * 1024 + c8) = o;
            }
            const bf16 *Qb = (const bf16*)(ws + WS_Q), *Kb = (const bf16*)(ws + WS_K), *Vb = (const bf16*)(ws + WS_V); bf16* ATTb = (bf16*)(ws + WS_ATT);
            for (int it = gw_o; it < MC * 8; it += NGW) attn_naive_item(Qb, Kb, Vb, ATTb, chunk, it >> 3, it & 7, lane_o);
        }
        SEAM(pb + 1);
        if (IN(pb + 2)) {
            unsigned char* ws = wsptr();
            pg8::Gemm g{(const bf16*)(ws + WS_ATT), (const bf16*)(ws + WS_WAO), MC, DM, ATTO}; pg8::StaticOrder S; S.init(MC, DM, opq(G), opq(bx));
            pg8::EpiGate<0> E{(bf16*)(ws + WS_T1), (const bf16*)(ws + WS_GA), nullptr, 1024};
            pg8::gemm_phase<pg8::EpiGate<0>, pg8::StaticOrder, true, true>(L, g, S, E);
        }
        SEAM(pb + 2);
        if (IN(pb + 3)) {
            unsigned char* ws = wsptr();
            pg8::Gemm g{(const bf16*)(ws + WS_CVIN), (const bf16*)(ws + WS_WCO), MC, DM, DM}; pg8::StaticOrder S; S.init(MC, DM, opq(G), opq(bx));
            pg8::EpiGate<1> E{(bf16*)(ws + WS_MRG), (const bf16*)(ws + WS_GC), (const bf16*)(ws + WS_T1), 1024};
            pg8::gemm_phase<pg8::EpiGate<1>, pg8::StaticOrder, true, true>(L, g, S, E);
        }
        SEAM(pb + 3);
        if (IN(pb + 4)) {
            unsigned char* ws = wsptr(); float* outc = outptr() + (size_t)chunk * MC * DM;
            const float* xc = (chunk == 0) ? inptr(0) : inptr(1) + (size_t)(chunk - 1) * MC * DM;
            pg8::Gemm g{(const bf16*)(ws + WS_MRG), (const bf16*)(ws + WS_WMO), MC, DM, DM}; pg8::StaticOrder S; S.init(MC, DM, opq(G), opq(bx));
            pg8::EpiRes E{xc, outc, (const float*)(ws + WS_MOD) + 2048, chunk};
            pg8::gemm_phase<pg8::EpiRes, pg8::StaticOrder, true, true>(L, g, S, E);
        }
        SEAM(pb + 4);
        if (IN(pb + 5)) {
            int lane_o = lane, gw_o = gw; asm volatile("" : "+v"(lane_o), "+s"(gw_o));
            unsigned char* ws = wsptr(); float* outc = outptr() + (size_t)chunk * MC * DM; const float* mod = (const float*)(ws + WS_MOD); const float* g2 = inptr(13);
            bf16* XN2b = (bf16*)(ws + WS_XN2);
            for (int r = gw_o; r < MC; r += NGW) { int bi, s, S; rowinfo(chunk, r, bi, s, S);
                norm_row_bf16(outc + (size_t)r * DM, XN2b + (size_t)r * DM, g2, mod + bi * 6144 + 4096, mod + bi * 6144 + 3072, lane_o); }
        }
        SEAM(pb + 5);
        if (IN(pb + 6)) {
            unsigned char* ws = wsptr();
            pg8::Gemm g{(const bf16*)(ws + WS_XN2), (const bf16*)(ws + WS_WMI), MC, DFF, DM}; pg8::StaticOrder S; S.init(MC, DFF, opq(G), opq(bx));
            pg8::EpiGate<2> E{(bf16*)(ws + WS_HDN), nullptr, nullptr, DFF};
            pg8::gemm_phase<pg8::EpiGate<2>, pg8::StaticOrder, true, true>(L, g, S, E);
        }
        SEAM(pb + 6);
        if (IN(pb + 7)) {
            unsigned char* ws = wsptr(); float* outc = outptr() + (size_t)chunk * MC * DM;
            pg8::Gemm g{(const bf16*)(ws + WS_HDN), (const bf16*)(ws + WS_WMO2), MC, DM, DFF}; pg8::StaticOrder S; S.init(MC, DM, opq(G), opq(bx));
            pg8::EpiRes E{outc, outc, (const float*)(ws + WS_MOD) + 5120, chunk};
            pg8::gemm_phase<pg8::EpiRes, pg8::StaticOrder, true, true>(L, g, S, E);
        }
        SEAM(pb + 7);
    }
    if (IN(NPHASE - 1)) {
        float* out = outptr(); const float* gf = inptr(16);
        for (int m = gw; m < MTOT; m += NGW) norm_row_f32(out + (size_t)m * DM, gf, lane);
    }
#undef IN
#undef SEAM
}

#ifndef MK_N_LAUNCHES
#define MK_N_LAUNCHES 1
#endif
extern "C" void kernel_launch(void* const* d_in, const int* in_sizes, int n_in, void* d_out, int out_size, void* d_ws, size_t ws_size, hipStream_t stream) {
    static int grid = 0;
    if (grid == 0) {
        if (n_in != 17 || out_size != MTOT * DM || ws_size < WS_END) { fprintf(stderr, "kernel_launch: unexpected shapes (n_in %d out %d ws %zu)\n", n_in, out_size, ws_size); grid = -1; return; }
        int dev = 0, cus = 0, per_cu = 0;
        if (hipGetDevice(&dev) != hipSuccess || hipDeviceGetAttribute(&cus, hipDeviceAttributeMultiprocessorCount, dev) != hipSuccess) { grid = -1; return; }
        if (hipFuncSetAttribute((const void*)mk_fwd, hipFuncAttributeMaxDynamicSharedMemorySize, LDS_BYTES) != hipSuccess) { fprintf(stderr, "kernel_launch: hipFuncSetAttribute failed\n"); grid = -1; return; }
        if (hipOccupancyMaxActiveBlocksPerMultiprocessor(&per_cu, (const void*)mk_fwd, NWAVES * 64, LDS_BYTES) != hipSuccess || per_cu < 1) { fprintf(stderr, "kernel_launch: occupancy query says %d\n", per_cu); (void)hipGetLastError(); per_cu = 1; }
        if (per_cu > 1) per_cu = 1;
        grid = cus * per_cu;
    }
    if (grid < 0) return;
    Args a{};
    for (int i = 0; i < 17; ++i) a.in[i] = (const float*)d_in[i];
    a.out = (float*)d_out; a.ws = (unsigned char*)d_ws;
    if (MK_N_LAUNCHES == 1) {
        a.ph_lo = 0; a.ph_hi = NPHASE;
        void* kargs[] = {&a};
        hipError_t e = hipLaunchCooperativeKernel((const void*)mk_fwd, dim3(grid), dim3(NWAVES * 64), kargs, LDS_BYTES, stream);
        if (e != hipSuccess) fprintf(stderr, "cooperative launch failed: %s (grid %d)\n", hipGetErrorString(e), grid);
    } else {
        for (int p = 0; p < NPHASE; ++p) { a.ph_lo = p; a.ph_hi = p + 1; hipLaunchKernelGGL(mk_fwd, dim3(grid), dim3(NWAVES * 64), LDS_BYTES, stream, a); }
    }
}
```

```cpp
#include <hip/hip_runtime.h>
#include <hip/hip_cooperative_groups.h>
#include <cstdio>
#include <cstdint>
namespace cg = cooperative_groups;
namespace pg8 {
#define PG8_LAS __attribute__((address_space(3)))
typedef unsigned short bf16_t;
typedef short bf16x8 __attribute__((ext_vector_type(8)));
typedef float f32x4 __attribute__((ext_vector_type(4)));
typedef unsigned u32x4 __attribute__((ext_vector_type(4)));
constexpr int BM = 256, BK = 64, HALF = 128, HTB = HALF * BK * 2  , STAGE_BYTES = 8 * HTB, NXCD = 8, WGM = 8;

__host__ __device__ __forceinline__ int lds_byte(int r, int c) { const int st = (r >> 4) * 2 + (c >> 5), rr = r & 15, cc = c & 31, ob = rr * 64 + cc * 2; return st * 1024 + (ob ^ (((ob >> 9) & 1) << 5)); }
__host__ __device__ __forceinline__ void stage_rc(int b, int& R, int& C) { const int st = b / 1024, sb = b % 1024, swz = sb ^ (((sb >> 9) & 1) << 5); R = (st >> 1) * 16 + swz / 64; C = (st & 1) * 32 + (swz % 64) / 2; }
__host__ __device__ __forceinline__ int perm32(int rho) { const int n = rho >> 4, i = rho & 15; return 8 * (i >> 2) + 4 * n + (i & 3); }

struct Unit { int pm, pn; };
struct Gemm { const bf16_t* A; const bf16_t* Bt; int M, N, K; };

struct StaticOrder {
    int nM, nN, nwg, G, c;
    __host__ __device__ void init(int M, int N, int G_, int c_) { nM = M / BM; nN = N / BM; nwg = nM * nN; G = G_; c = c_; }
    __host__ __device__ bool next(int i, Unit& u) const {
        const long L = (long)i * G + c; if (L >= nwg) return false;
        int wgid = (int)L; { const int q = nwg / NXCD, r = nwg % NXCD, xcd = wgid % NXCD, off = wgid / NXCD; wgid = (xcd < r ? xcd * (q + 1) : r * (q + 1) + (xcd - r) * q) + off; }
        const int nig = WGM * nN, gid = wgid / nig, fm = gid * WGM, gsz = (nM - fm) < WGM ? (nM - fm) : WGM;
        u.pm = fm + ((wgid % nig) % gsz); u.pn = (wgid % nig) / gsz; return true;
    }
    __device__ __forceinline__ void a_ready(const Unit&) const {}
    __device__ __forceinline__ void done(const Unit&) const {}
};

__device__ __forceinline__ unsigned cvt_pk_bf16(float lo, float hi) { unsigned r; asm volatile("v_cvt_pk_bf16_f32 %0, %1, %2" : "=v"(r) : "v"(lo), "v"(hi)); return r; }
typedef float f32x2 __attribute__((ext_vector_type(2)));
template <class Epi, class Sched, bool ALIGN_EPI = false, bool SP2 = false>
__device__ __forceinline__ void gemm_phase(PG8_LAS unsigned char* lds, const Gemm g, const Sched& S, const Epi& E) {
    int tid_ = threadIdx.x; asm volatile("" : "+v"(tid_));
    const int tid = tid_, wid = __builtin_amdgcn_readfirstlane(tid >> 6), lane = tid & 63, wr = wid >> 2, wc = wid & 3, fr = lane & 15, fq = lane >> 4;
    const int K = g.K, nt = K / BK;
    unsigned voffA[2], voffB[2];
#pragma unroll
    for (int i = 0; i < 2; ++i) { int R, C; stage_rc(tid * 16 + i * 8192, R, C); const int Rb = Epi::PERM ? ((R & ~31) + perm32(R & 31)) : R;
        voffA[i] = (unsigned)(R * K + C) * 2u; voffB[i] = (unsigned)(Rb * K + C) * 2u; }
    const size_t kstep = (size_t)(BK * 2);
    const size_t hstep = (size_t)HALF * K * 2;
    const size_t tstep = 2 * hstep;
    const unsigned ldsw = (unsigned)wid * 1024u;
    const int aoff = lds_byte(wr * 64 + fr, fq * 8), boff = lds_byte(wc * 32 + fr, fq * 8);
#define PG8_SA(b, h) (((b) * 2 + (h)) * HTB)
#define PG8_SB(b, h) ((4 + (b) * 2 + (h)) * HTB)
#define PG8_STAGE(bufoff, gbase, voff) do { _Pragma("unroll") for (int _i = 0; _i < 2; ++_i) \
        __builtin_amdgcn_global_load_lds((const unsigned*)((const char*)(gbase) + (voff)[_i]), (PG8_LAS unsigned*)(lds + (bufoff) + ldsw + _i * 8192), 16, 0, 0); } while (0)
#define PG8_LDA(dst, b, h) do { _Pragma("unroll") for (int m = 0; m < 4; ++m) _Pragma("unroll") for (int k = 0; k < 2; ++k) dst[m][k] = *(const PG8_LAS bf16x8*)(lds + PG8_SA(b, h) + aoff + m * 2048 + k * 1024); } while (0)
#define PG8_LDB(dst, b, h) do { _Pragma("unroll") for (int n = 0; n < 2; ++n) _Pragma("unroll") for (int k = 0; k < 2; ++k) dst[n][k] = *(const PG8_LAS bf16x8*)(lds + PG8_SB(b, h) + boff + n * 2048 + k * 1024); } while (0)
#define PG8_MMA(ai, bj, At, Bt) do { __builtin_amdgcn_s_setprio(1); _Pragma("unroll") for (int m = 0; m < 4; ++m) _Pragma("unroll") for (int n = 0; n < 2; ++n) _Pragma("unroll") for (int k = 0; k < 2; ++k) \
        acc[ai][bj][m][n] = __builtin_amdgcn_mfma_f32_16x16x32_bf16(Bt[n][k], At[m][k], acc[ai][bj][m][n], 0, 0, 0); __builtin_amdgcn_s_setprio(0); } while (0)
#define PG8_WAIT_V(n) asm volatile("s_waitcnt vmcnt(" #n ")" ::: "memory")
#define PG8_WAIT_L(n) asm volatile("s_waitcnt lgkmcnt(" #n ")" ::: "memory")
#define PG8_BAR __builtin_amdgcn_s_barrier()
#define PG8_SCHED __builtin_amdgcn_sched_barrier(0)
    Unit cur, nxt; int ui = 0;
    if (!S.next(0, cur)) return;
    f32x4 acc[2][2][4][2];
#pragma unroll
    for (int a = 0; a < 2; ++a)
#pragma unroll
        for (int b = 0; b < 2; ++b)
#pragma unroll
            for (int m = 0; m < 4; ++m)
#pragma unroll
                for (int n = 0; n < 2; ++n) acc[a][b][m][n] = (f32x4){0.f, 0.f, 0.f, 0.f};
    bf16x8 At[4][2], B0[2][2], B1[2][2];
    const char* cA = (const char*)g.A + (size_t)cur.pm * tstep; const char* cB = (const char*)g.Bt + (size_t)cur.pn * tstep;
    S.a_ready(cur);
    if constexpr (SP2) {
        PG8_STAGE(PG8_SB(0, 0), cB, voffB); PG8_STAGE(PG8_SB(0, 1), cB + hstep, voffB); PG8_STAGE(PG8_SA(0, 0), cA, voffA); PG8_STAGE(PG8_SA(0, 1), cA + hstep, voffA);
        if (wr == 1) PG8_BAR;
        PG8_WAIT_V(2); PG8_BAR;
        PG8_STAGE(PG8_SB(1, 0), cB + kstep, voffB); PG8_STAGE(PG8_SA(1, 0), cA + kstep, voffA); PG8_STAGE(PG8_SB(1, 1), cB + hstep + kstep, voffB);
        PG8_WAIT_V(6); PG8_BAR;
    } else {
        PG8_STAGE(PG8_SB(0, 0), cB, voffB); PG8_STAGE(PG8_SA(0, 0), cA, voffA); PG8_STAGE(PG8_SB(0, 1), cB + hstep, voffB); PG8_STAGE(PG8_SA(0, 1), cA + hstep, voffA);
        if (wr == 1) PG8_BAR;
        PG8_WAIT_V(4); PG8_BAR;
        PG8_STAGE(PG8_SB(1, 0), cB + kstep, voffB); PG8_STAGE(PG8_SA(1, 0), cA + kstep, voffA); PG8_STAGE(PG8_SB(1, 1), cB + hstep + kstep, voffB);
        PG8_WAIT_V(6); PG8_BAR;
    }
    for (;;) {
        const bool has_next = S.next(ui + 1, nxt);
        const char* nA = has_next ? (const char*)g.A + (size_t)nxt.pm * tstep : cA; const char* nB = has_next ? (const char*)g.Bt + (size_t)nxt.pn * tstep : cB;
        for (int t = 0; t < nt; t += 2) {
            const bool last = (t == nt - 2);
            const char* a1 = cA + (size_t)(t + 1) * kstep;
            const char* a2 = last ? nA : cA + (size_t)(t + 2) * kstep; const char* b2 = last ? nB : cB + (size_t)(t + 2) * kstep;
            const char* a3 = a2 + kstep; const char* b3 = b2 + kstep;
            if (last && has_next) S.a_ready(nxt);
            if constexpr (SP2) {
            PG8_LDB(B0, 0, 0); PG8_LDB(B1, 0, 1); PG8_SCHED; PG8_LDA(At, 0, 0); PG8_STAGE(PG8_SA(1, 1), a1 + hstep, voffA);
            PG8_WAIT_V(8); PG8_WAIT_L(0); PG8_BAR; PG8_MMA(0, 0, At, B0); PG8_MMA(0, 1, At, B1); PG8_BAR; PG8_SCHED;
            PG8_LDA(At, 0, 1); PG8_STAGE(PG8_SB(0, 0), b2, voffB); PG8_STAGE(PG8_SB(0, 1), b2 + hstep, voffB); PG8_STAGE(PG8_SA(0, 0), a2, voffA);
            PG8_WAIT_V(8); PG8_WAIT_L(0); PG8_BAR; PG8_MMA(1, 0, At, B0); PG8_MMA(1, 1, At, B1); PG8_BAR; PG8_SCHED;
            PG8_LDB(B0, 1, 0); PG8_LDB(B1, 1, 1); PG8_SCHED; PG8_LDA(At, 1, 0); PG8_STAGE(PG8_SA(0, 1), a2 + hstep, voffA);
            PG8_WAIT_V(8); PG8_WAIT_L(0); PG8_BAR; PG8_MMA(0, 0, At, B0); PG8_MMA(0, 1, At, B1); PG8_BAR; PG8_SCHED;
            PG8_LDA(At, 1, 1); PG8_STAGE(PG8_SB(1, 0), b3, voffB); PG8_STAGE(PG8_SB(1, 1), b3 + hstep, voffB); PG8_STAGE(PG8_SA(1, 0), a3, voffA);
            PG8_WAIT_V(8); PG8_WAIT_L(0); PG8_BAR; PG8_MMA(1, 0, At, B0); PG8_MMA(1, 1, At, B1); PG8_BAR; PG8_SCHED;
            } else {
            PG8_LDB(B0, 0, 0); PG8_SCHED; PG8_LDA(At, 0, 0); PG8_STAGE(PG8_SA(1, 1), a1 + hstep, voffA);
            PG8_WAIT_L(8); PG8_BAR; PG8_WAIT_L(0); PG8_MMA(0, 0, At, B0); PG8_BAR; PG8_SCHED;
            PG8_LDB(B1, 0, 1); PG8_STAGE(PG8_SB(0, 0), b2, voffB);
            PG8_BAR; PG8_WAIT_L(0); PG8_MMA(0, 1, At, B1); PG8_BAR;
            PG8_LDA(At, 0, 1); PG8_STAGE(PG8_SA(0, 0), a2, voffA);
            PG8_BAR; PG8_WAIT_L(0); PG8_MMA(1, 0, At, B0); PG8_BAR; PG8_SCHED;
            PG8_STAGE(PG8_SB(0, 1), b2 + hstep, voffB);
            PG8_WAIT_V(6); PG8_BAR; PG8_MMA(1, 1, At, B1); PG8_BAR;
            PG8_LDB(B0, 1, 0); PG8_SCHED; PG8_LDA(At, 1, 0); PG8_STAGE(PG8_SA(0, 1), a2 + hstep, voffA);
            PG8_WAIT_L(8); PG8_BAR; PG8_WAIT_L(0); PG8_MMA(0, 0, At, B0); PG8_BAR; PG8_SCHED;
            PG8_LDB(B1, 1, 1); PG8_STAGE(PG8_SB(1, 0), b3, voffB);
            PG8_BAR; PG8_WAIT_L(0); PG8_MMA(0, 1, At, B1); PG8_BAR;
            PG8_LDA(At, 1, 1); PG8_STAGE(PG8_SA(1, 0), a3, voffA);
            PG8_BAR; PG8_WAIT_L(0); PG8_MMA(1, 0, At, B0); PG8_BAR; PG8_SCHED;
            PG8_STAGE(PG8_SB(1, 1), b3 + hstep, voffB);
            PG8_WAIT_V(6); PG8_BAR; PG8_MMA(1, 1, At, B1); PG8_BAR;
            }
        }
        if constexpr (ALIGN_EPI) { if (wr == 0) PG8_BAR; }
        if constexpr (!Epi::AFTER_DRAIN) { E(acc, cur, wr, wc, fr, fq); S.done(cur); }
        if (!has_next) break;
#pragma unroll
        for (int a = 0; a < 2; ++a)
#pragma unroll
            for (int b = 0; b < 2; ++b)
#pragma unroll
                for (int m = 0; m < 4; ++m)
#pragma unroll
                    for (int n = 0; n < 2; ++n) acc[a][b][m][n] = (f32x4){0.f, 0.f, 0.f, 0.f};
        cur = nxt; cA = nA; cB = nB; ++ui;
        if constexpr (ALIGN_EPI) { if (wr == 1) PG8_BAR; }
    }
    PG8_WAIT_V(0);
    if constexpr (!ALIGN_EPI) { if (wr == 0) PG8_BAR; }
    PG8_BAR;
    if constexpr (Epi::AFTER_DRAIN) { E.fused(acc, cur, wr, wc, fr, fq, lds, wid, lane); S.done(cur); }
#undef PG8_SA
#undef PG8_SB
#undef PG8_STAGE
#undef PG8_LDA
#undef PG8_LDB
#undef PG8_MMA
#undef PG8_WAIT_V
#undef PG8_WAIT_L
#undef PG8_BAR
#undef PG8_SCHED
}
}

#define GAS __attribute__((address_space(1)))
#define LAS __attribute__((address_space(3)))
typedef unsigned short bf16;
typedef unsigned v4u __attribute__((ext_vector_type(4)));
typedef unsigned v2u __attribute__((ext_vector_type(2)));
typedef float f32x4 __attribute__((ext_vector_type(4)));
constexpr int DM = 1024, MTOT = 49152, MC = 16384, NCHUNK = 3, NB = 6;
constexpr int NIN = 9728, DFF = 4096, QW = 1536, ATTO = 512;
constexpr float EPS = 1e-6f;
constexpr float QSCALE = 0.125f * 1.4426950408889634f;
constexpr int NWAVES = 8;
constexpr size_t MiB = 1u << 20;
constexpr size_t WS_MOD = 1 * MiB, WS_ROPE = 2 * MiB, WS_WIN = 6 * MiB, WS_WAO = 25 * MiB, WS_WCO = 26 * MiB, WS_WMO = 28 * MiB, WS_WMI = 30 * MiB, WS_WMO2 = 38 * MiB;
constexpr size_t WS_Q = 48 * MiB, WS_K = 96 * MiB, WS_V = 144 * MiB, WS_U = 192 * MiB, WS_BG = 224 * MiB, WS_GA = 256 * MiB, WS_GC = 288 * MiB;
constexpr size_t WS_ATT = 320 * MiB, WS_CVIN = 336 * MiB, WS_T1 = 368 * MiB, WS_MRG = 400 * MiB, WS_XN2 = 432 * MiB, WS_END = 464 * MiB;
constexpr size_t WS_LSE = 46 * MiB;
constexpr size_t WS_HDN = 48 * MiB;
constexpr int LDS_BYTES = 147456;

__device__ __forceinline__ unsigned pkbf(float lo, float hi) { unsigned r; asm volatile("v_cvt_pk_bf16_f32 %0, %1, %2" : "=v"(r) : "v"(lo), "v"(hi)); return r; }
__device__ __forceinline__ float bflo(unsigned u) { return __builtin_bit_cast(float, u << 16); }
__device__ __forceinline__ float bfhi(unsigned u) { return __builtin_bit_cast(float, u & 0xffff0000u); }
__device__ __forceinline__ float wave_sum(float v) {
#pragma unroll
    for (int o = 1; o < 64; o <<= 1) v += __shfl_xor(v, o);
    return v;
}
__device__ __forceinline__ float wave_max(float v) {
#pragma unroll
    for (int o = 1; o < 64; o <<= 1) v = fmaxf(v, __shfl_xor(v, o));
    return v;
}
__device__ __forceinline__ float sigmoidf_(float x) { return __builtin_amdgcn_rcpf(1.f + __expf(-x)); }
__device__ __forceinline__ void rowinfo(int chunk, int r, int& bi, int& s, int& S) { if (chunk == 0) { bi = r >> 12; s = r & 4095; S = 4096; } else { bi = 3 + chunk; s = r; S = 16384; } }

namespace pg8 {
struct EpiIn {
    static constexpr bool PERM = true, AFTER_DRAIN = false;
    int chunk; unsigned char* ws;
    __device__ __forceinline__ void operator()(const f32x4 (&acc)[2][2][4][2], const Unit& u, int wr, int wc, int fr, int fq) const {
        const int pn = u.pn; const int row0 = u.pm * BM + wr * 64 + fr;
        bf16_t* const Q = (bf16_t*)(ws + WS_Q); bf16_t* const K = (bf16_t*)(ws + WS_K); bf16_t* const V = (bf16_t*)(ws + WS_V); bf16_t* const U = (bf16_t*)(ws + WS_U);
        bf16_t* const BG = (bf16_t*)(ws + WS_BG); bf16_t* const GA = (bf16_t*)(ws + WS_GA); bf16_t* const GC = (bf16_t*)(ws + WS_GC); const float* const rope = (const float*)(ws + WS_ROPE);
        if (pn < 12) {
            bf16_t* base = (pn < 6) ? Q : K; const int hd = 4 * (pn < 6 ? pn : pn - 6) + wc; const float sc = (pn < 6) ? QSCALE : 1.f;
#pragma unroll
            for (int ai = 0; ai < 2; ++ai)
#pragma unroll
                for (int m = 0; m < 4; ++m) {
                    const int row = row0 + ai * HALF + m * 16; const int s = (chunk == 0) ? (row & 4095) : row;
                    const f32x4* rp = (const f32x4*)(rope + (size_t)s * 64 + 16 * fq);
                    const f32x4 c0 = rp[0], c1 = rp[1], c2 = rp[2], c3 = rp[3];
                    const f32x4 a0 = acc[ai][0][m][0], a1 = acc[ai][0][m][1], b0 = acc[ai][1][m][0], b1 = acc[ai][1][m][1];
                    u32x4 w1, w2;
                    w1.x = cvt_pk_bf16((a0[0] * c0[0] - b0[0] * c0[1]) * sc, (a0[1] * c0[2] - b0[1] * c0[3]) * sc);
                    w1.y = cvt_pk_bf16((a0[2] * c1[0] - b0[2] * c1[1]) * sc, (a0[3] * c1[2] - b0[3] * c1[3]) * sc);
                    w1.z = cvt_pk_bf16((a1[0] * c2[0] - b1[0] * c2[1]) * sc, (a1[1] * c2[2] - b1[1] * c2[3]) * sc);
                    w1.w = cvt_pk_bf16((a1[2] * c3[0] - b1[2] * c3[1]) * sc, (a1[3] * c3[2] - b1[3] * c3[3]) * sc);
                    w2.x = cvt_pk_bf16((b0[0] * c0[0] + a0[0] * c0[1]) * sc, (b0[1] * c0[2] + a0[1] * c0[3]) * sc);
                    w2.y = cvt_pk_bf16((b0[2] * c1[0] + a0[2] * c1[1]) * sc, (b0[3] * c1[2] + a0[3] * c1[3]) * sc);
                    w2.z = cvt_pk_bf16((b1[0] * c2[0] + a1[0] * c2[1]) * sc, (b1[1] * c2[2] + a1[1] * c2[3]) * sc);
                    w2.w = cvt_pk_bf16((b1[2] * c3[0] + a1[2] * c3[1]) * sc, (b1[3] * c3[2] + a1[3] * c3[3]) * sc);
                    bf16_t* p = base + (size_t)row * 1536 + hd * 64 + 8 * fq;
                    *(u32x4*)p = w1; *(u32x4*)(p + 32) = w2;
                }
        } else if (pn < 18) {
#pragma unroll
            for (int ai = 0; ai < 2; ++ai)
#pragma unroll
                for (int m = 0; m < 4; ++m)
#pragma unroll
                    for (int bj = 0; bj < 2; ++bj) {
                        const int row = row0 + ai * HALF + m * 16; const f32x4 v0 = acc[ai][bj][m][0], v1 = acc[ai][bj][m][1];
                        u32x4 w; w.x = cvt_pk_bf16(v0[0], v0[1]); w.y = cvt_pk_bf16(v0[2], v0[3]); w.z = cvt_pk_bf16(v1[0], v1[1]); w.w = cvt_pk_bf16(v1[2], v1[3]);
                        *(u32x4*)(V + (size_t)row * 1536 + (pn - 12) * 256 + bj * HALF + wc * 32 + 8 * fq) = w;
                    }
        } else if (pn < 26) {
#pragma unroll
            for (int ai = 0; ai < 2; ++ai)
#pragma unroll
                for (int m = 0; m < 4; ++m) {
                    const int row = row0 + ai * HALF + m * 16; const f32x4 v0 = acc[ai][0][m][0] * acc[ai][1][m][0], v1 = acc[ai][0][m][1] * acc[ai][1][m][1];
                    u32x4 w; w.x = cvt_pk_bf16(v0[0], v0[1]); w.y = cvt_pk_bf16(v0[2], v0[3]); w.z = cvt_pk_bf16(v1[0], v1[1]); w.w = cvt_pk_bf16(v1[2], v1[3]);
                    *(u32x4*)(U + (size_t)row * 1024 + (pn - 18) * 128 + wc * 32 + 8 * fq) = w;
                }
        } else {
            bf16_t* base = (pn < 30) ? BG : (pn < 34) ? GA : GC; const int ct = (pn < 30) ? pn - 26 : (pn < 34) ? pn - 30 : pn - 34; const bool sg = pn >= 30;
#pragma unroll
            for (int ai = 0; ai < 2; ++ai)
#pragma unroll
                for (int m = 0; m < 4; ++m)
#pragma unroll
                    for (int bj = 0; bj < 2; ++bj) {
                        const int row = row0 + ai * HALF + m * 16; f32x4 v0 = acc[ai][bj][m][0], v1 = acc[ai][bj][m][1];
                        if (sg) {
#pragma unroll
                            for (int e = 0; e < 4; ++e) { v0[e] = sigmoidf_(v0[e]); v1[e] = sigmoidf_(v1[e]); } }
                        u32x4 w; w.x = cvt_pk_bf16(v0[0], v0[1]); w.y = cvt_pk_bf16(v0[2], v0[3]); w.z = cvt_pk_bf16(v1[0], v1[1]); w.w = cvt_pk_bf16(v1[2], v1[3]);
                        *(u32x4*)(base + (size_t)row * 1024 + ct * 256 + bj * HALF + wc * 32 + 8 * fq) = w;
                    }
        }
    }
};
template <int MODE> struct EpiGate {
    static constexpr bool PERM = true, AFTER_DRAIN = false;
    bf16_t* O; const bf16_t* G; const bf16_t* ADD; int ldc;
    __device__ __forceinline__ void operator()(const f32x4 (&acc)[2][2][4][2], const Unit& u, int wr, int wc, int fr, int fq) const {
        const int row0 = u.pm * BM + wr * 64 + fr, col0 = u.pn * BM + wc * 32 + 8 * fq;
#pragma unroll
        for (int ai = 0; ai < 2; ++ai)
#pragma unroll
            for (int m = 0; m < 4; ++m)
#pragma unroll
                for (int bj = 0; bj < 2; ++bj) {
                    const size_t idx = (size_t)(row0 + ai * HALF + m * 16) * ldc + col0 + bj * HALF;
                    f32x4 v0 = acc[ai][bj][m][0], v1 = acc[ai][bj][m][1];
                    if (MODE == 2) {
#pragma unroll
                        for (int e = 0; e < 4; ++e) { const float a = fmaxf(v0[e], 0.f), b = fmaxf(v1[e], 0.f); v0[e] = a * a; v1[e] = b * b; }
                    } else {
                        const u32x4 g = *(const u32x4*)(G + idx);
                        v0[0] *= bflo(g.x); v0[1] *= bfhi(g.x); v0[2] *= bflo(g.y); v0[3] *= bfhi(g.y); v1[0] *= bflo(g.z); v1[1] *= bfhi(g.z); v1[2] *= bflo(g.w); v1[3] *= bfhi(g.w);
                        if (MODE == 1) { const u32x4 t = *(const u32x4*)(ADD + idx);
                            v0[0] += bflo(t.x); v0[1] += bfhi(t.x); v0[2] += bflo(t.y); v0[3] += bfhi(t.y); v1[0] += bflo(t.z); v1[1] += bfhi(t.z); v1[2] += bflo(t.w); v1[3] += bfhi(t.w); }
                    }
                    u32x4 w; w.x = cvt_pk_bf16(v0[0], v0[1]); w.y = cvt_pk_bf16(v0[2], v0[3]); w.z = cvt_pk_bf16(v1[0], v1[1]); w.w = cvt_pk_bf16(v1[2], v1[3]);
                    *(u32x4*)(O + idx) = w;
                }
    }
};
struct EpiRes {
    static constexpr bool PERM = false, AFTER_DRAIN = false;
    const float* base; float* out; const float* gt0; int chunk;
    __device__ __forceinline__ void operator()(const f32x4 (&acc)[2][2][4][2], const Unit& u, int wr, int wc, int fr, int fq) const {
        const int row0 = u.pm * BM + wr * 64 + fr, col0 = u.pn * BM + wc * 32 + 4 * fq;
        const int bi = (chunk == 0) ? ((u.pm * BM) >> 12) : 3 + chunk;
        const float* gt = gt0 + bi * 6144;
#pragma unroll
        for (int bj = 0; bj < 2; ++bj)
#pragma unroll
            for (int n = 0; n < 2; ++n) {
                const int col = col0 + bj * HALF + n * 16; const f32x4 g = *(const f32x4*)(gt + col);
#pragma unroll
                for (int ai = 0; ai < 2; ++ai)
#pragma unroll
                    for (int m = 0; m < 4; ++m) { const size_t idx = (size_t)(row0 + ai * HALF + m * 16) * 1024 + col;
                        const f32x4 b = *(const f32x4*)(base + idx); *(f32x4*)(out + idx) = b + g * acc[ai][bj][m][n]; }
            }
    }
};
}

struct Args { const float* in[17]; float* out; unsigned char* ws; int ph_lo, ph_hi; };

__device__ __forceinline__ int win_dst_row(int n0) {
    if (n0 < 3072) { const int tile = n0 >> 8, sb = (n0 >> 5) & 7, hd = sb >> 1, half = sb & 1; return (tile << 8) + ((4 * half + hd) << 5); }
    if (n0 < 4608) return n0;
    if (n0 < 5632) { const int o = n0 - 4608; return (18 + (o >> 7)) * 256 + (o & 127); }
    if (n0 < 6656) { const int o = n0 - 5632; return (18 + (o >> 7)) * 256 + 128 + (o & 127); }
    return n0;
}
__device__ __forceinline__ void p0_transpose_item(const float* W, int K, int N, bf16* WT, bool remap, LAS float* scr, int item, int lane) {
    const int nblk = N / 32, kb = item / nblk, nb = item % nblk, k0 = 64 * kb, n0 = 32 * nb;
    const int d0 = remap ? win_dst_row(n0) : n0;
#pragma unroll 8
    for (int i = 0; i < 32; ++i) { const int kk = 2 * i + (lane >> 5); scr[kk * 33 + (lane & 31)] = W[(size_t)(k0 + kk) * N + n0 + (lane & 31)]; }
    asm volatile("s_waitcnt lgkmcnt(0)" ::: "memory");
    const int c = lane & 7;
#pragma unroll
    for (int j = 0; j < 4; ++j) { const int n = (lane >> 3) + 8 * j; const LAS float* s = scr + (8 * c) * 33 + n;
        v4u o; o.x = pkbf(s[0 * 33], s[1 * 33]); o.y = pkbf(s[2 * 33], s[3 * 33]); o.z = pkbf(s[4 * 33], s[5 * 33]); o.w = pkbf(s[6 * 33], s[7 * 33]);
        *(v4u*)(WT + (size_t)(d0 + n) * K + k0 + 8 * c) = o; }
    asm volatile("s_waitcnt lgkmcnt(0)" ::: "memory");
}
__device__ __forceinline__ void norm_row_bf16(const float* xrow, bf16* orow, const float* g, const float* sc, const float* sh, int lane) {
    const f32x4* xr = (const f32x4*)xrow + lane; f32x4 v[4]; float s = 0.f;
#pragma unroll
    for (int j = 0; j < 4; ++j) { v[j] = xr[64 * j]; s += (v[j].x * v[j].x + v[j].y * v[j].y) + (v[j].z * v[j].z + v[j].w * v[j].w); }
    const float rstd = 1.f / sqrtf(wave_sum(s) * (1.f / 1024.f) + EPS);
    unsigned long long* o8 = (unsigned long long*)orow + lane;
#pragma unroll
    for (int j = 0; j < 4; ++j) {
        const f32x4 gg = ((const f32x4*)g)[lane + 64 * j], cc = ((const f32x4*)sc)[lane + 64 * j], hh = ((const f32x4*)sh)[lane + 64 * j];
        const f32x4 y = v[j] * rstd * gg * (cc + 1.0f) + hh;
        o8[64 * j] = (unsigned long long)pkbf(y.x, y.y) | ((unsigned long long)pkbf(y.z, y.w) << 32);
    }
}
__device__ __forceinline__ void norm_row_f32(float* xrow, const float* g, int lane) {
    f32x4* xr = (f32x4*)xrow + lane; f32x4 v[4]; float s = 0.f;
#pragma unroll
    for (int j = 0; j < 4; ++j) { v[j] = xr[64 * j]; s += (v[j].x * v[j].x + v[j].y * v[j].y) + (v[j].z * v[j].z + v[j].w * v[j].w); }
    const float rstd = 1.f / sqrtf(wave_sum(s) * (1.f / 1024.f) + EPS);
#pragma unroll
    for (int j = 0; j < 4; ++j) { const f32x4 gg = ((const f32x4*)g)[lane + 64 * j]; xr[64 * j] = v[j] * rstd * gg; }
}

typedef short bf16x8_t __attribute__((ext_vector_type(8)));
typedef short s16x4_t __attribute__((ext_vector_type(4)));
typedef float f32x16_t __attribute__((ext_vector_type(16)));
constexpr int AT_V = 49152;
__device__ __forceinline__ int crow_(int r, int hi) { return (r & 3) + 8 * (r >> 2) + 4 * hi; }
__device__ __forceinline__ s16x4_t vtr_(LAS const unsigned char* p) { return __builtin_bit_cast(s16x4_t, __builtin_amdgcn_ds_read_tr16_b64_v4i16((LAS s16x4_t*)p)); }
__device__ __forceinline__ void attn_unit(LAS unsigned char* L, unsigned char* ws, int chunk, int u, int lane, int wave) {
    const int S = (chunk == 0) ? 4096 : 16384, upb = S >> 8;
    const int j = u % upb, bh = u / upb, head = bh % 24, b = bh / 24;
    const int dsh = 2 * (head >> 3), Ls = S >> dsh, nqb = Ls >> 8;
    const int rho = j / nqb, qb = j % nqb, l0 = qb << 8, rb = b * 4096 + rho;
    const bf16* Qh = (const bf16*)(ws + WS_Q) + head * 64; const bf16* Kh = (const bf16*)(ws + WS_K) + head * 64; const bf16* Vh = (const bf16*)(ws + WS_V) + head * 64;
    const int r32 = lane & 31, hi = lane >> 5;
    v4u kv[6], vv[6];
    const int g8 = lane >> 3, i8 = lane & 7;
    const int kkl = wave * 8 + i8, kch = g8;
    const int vkl = wave * 8 + 2 * (g8 >> 1) + (i8 >> 2), vch = 4 * (g8 & 1) + (i8 & 3);
#pragma unroll
    for (int p = 0; p < 6; ++p) {
        const int lk = l0 - 64 + p * 64 + kkl; kv[p] = (v4u){0u, 0u, 0u, 0u};
        if (lk >= 0 && lk < Ls) kv[p] = *(const v4u*)(Kh + (size_t)(rb + (lk << dsh)) * QW + kch * 8);
        const int lv = l0 - 64 + p * 64 + vkl; vv[p] = (v4u){0u, 0u, 0u, 0u};
        if (lv >= 0 && lv < Ls) vv[p] = *(const v4u*)(Vh + (size_t)(rb + (lv << dsh)) * QW + vch * 8);
    }
    const int lq = l0 + 32 * wave + r32; const size_t qrow = (size_t)(rb + (lq << dsh));
    bf16x8_t qr[4];
#pragma unroll
    for (int d0 = 0; d0 < 4; ++d0) qr[d0] = *(const bf16x8_t*)(Qh + qrow * QW + 16 * d0 + 8 * hi);
#pragma unroll
    for (int p = 0; p < 6; ++p) {
        *(LAS v4u*)(L + (kch * 384 + p * 64 + kkl) * 16) = kv[p];
        *(LAS v4u*)(L + AT_V + (vch >> 2) * 24576 + (p * 64 + vkl) * 64 + (vch & 3) * 16) = vv[p];
    }
    __syncthreads();
    f32x16_t p[5];
#pragma unroll
    for (int kb = 0; kb < 5; ++kb) {
        f32x16_t a = {0.f, 0.f, 0.f, 0.f, 0.f, 0.f, 0.f, 0.f, 0.f, 0.f, 0.f, 0.f, 0.f, 0.f, 0.f, 0.f};
#pragma unroll
        for (int d0 = 0; d0 < 4; ++d0) { const bf16x8_t kf = *(LAS const bf16x8_t*)(L + (2 * d0 + hi) * 6144 + (32 * wave + 32 * kb + r32) * 16);
            a = __builtin_amdgcn_mfma_f32_32x32x16_bf16(kf, qr[d0], a, 0, 0, 0); }
        p[kb] = a;
    }
#pragma unroll
    for (int r = 0; r < 16; ++r) { const int cr = crow_(r, hi); if (cr < r32) p[0][r] = -INFINITY; if (cr > r32) p[4][r] = -INFINITY; }
    const int kbase = l0 + 32 * wave - 64;
    if (kbase < 0 || kbase + 160 > Ls) {
#pragma unroll
        for (int kb = 0; kb < 5; ++kb)
#pragma unroll
            for (int r = 0; r < 16; ++r) { const int lk = kbase + 32 * kb + crow_(r, hi); if (lk < 0 || lk >= Ls) p[kb][r] = -INFINITY; }
    }
    float mx = -INFINITY;
#pragma unroll
    for (int kb = 0; kb < 5; ++kb)
#pragma unroll
        for (int r = 0; r < 16; ++r) mx = fmaxf(mx, p[kb][r]);
    mx = fmaxf(mx, __shfl_xor(mx, 32));
    float lsum = 0.f;
#pragma unroll
    for (int kb = 0; kb < 5; ++kb)
#pragma unroll
        for (int r = 0; r < 16; ++r) { const float e = __builtin_amdgcn_exp2f(p[kb][r] - mx); p[kb][r] = e; lsum += e; }
    lsum += __shfl_xor(lsum, 32);
    f32x16_t ot[2];
    ot[0] = (f32x16_t){0.f, 0.f, 0.f, 0.f, 0.f, 0.f, 0.f, 0.f, 0.f, 0.f, 0.f, 0.f, 0.f, 0.f, 0.f, 0.f}; ot[1] = ot[0];
    LAS const unsigned char* vbase = L + AT_V + ((lane >> 4) & 1) * 32 + (lane & 3) * 8 + (4 * hi + ((lane & 15) >> 2)) * 64 + (32 * wave) * 64;
#pragma unroll
    for (int kb = 0; kb < 5; ++kb)
#pragma unroll
        for (int ks = 0; ks < 2; ++ks) {
            v4u pw; pw.x = pkbf(p[kb][8 * ks + 0], p[kb][8 * ks + 1]); pw.y = pkbf(p[kb][8 * ks + 2], p[kb][8 * ks + 3]); pw.z = pkbf(p[kb][8 * ks + 4], p[kb][8 * ks + 5]); pw.w = pkbf(p[kb][8 * ks + 6], p[kb][8 * ks + 7]);
            const bf16x8_t pf = __builtin_bit_cast(bf16x8_t, pw);
#pragma unroll
            for (int c = 0; c < 2; ++c) {
                LAS const unsigned char* vp = vbase + c * 24576 + (32 * kb + 16 * ks) * 64;
                const s16x4_t lo4 = vtr_(vp), hi4 = vtr_(vp + 8 * 64);
                const bf16x8_t vf = (bf16x8_t){lo4[0], lo4[1], lo4[2], lo4[3], hi4[0], hi4[1], hi4[2], hi4[3]};
                ot[c] = __builtin_amdgcn_mfma_f32_32x32x16_bf16(vf, pf, ot[c], 0, 0, 0);
            }
        }
    const float inv = 1.f / lsum;
    bf16* Oh = (bf16*)(ws + WS_Q) + head * 64 + qrow * QW;
#pragma unroll
    for (int c = 0; c < 2; ++c)
#pragma unroll
        for (int r4 = 0; r4 < 4; ++r4) {
            v2u w; w.x = pkbf(ot[c][4 * r4 + 0] * inv, ot[c][4 * r4 + 1] * inv); w.y = pkbf(ot[c][4 * r4 + 2] * inv, ot[c][4 * r4 + 3] * inv);
            *(v2u*)(Oh + 32 * c + 8 * r4 + 4 * hi) = w;
        }
    if (hi == 0) ((float*)(ws + WS_LSE))[qrow * 24 + head] = mx + __builtin_amdgcn_logf(lsum);
    __syncthreads();
}

constexpr int NPHASE = 2 + 8 * NCHUNK + 1;
typedef __attribute__((address_space(4))) const unsigned char kconst_t;
__device__ __forceinline__ const float* inptr(int i) { kconst_t* kp = (kconst_t*)__builtin_amdgcn_kernarg_segment_ptr(); asm volatile("" : "+s"(kp)); return *(const float* const __attribute__((address_space(4)))*)(kp + 8 * i); }
__device__ __forceinline__ int opq(int v) { asm volatile("" : "+s"(v)); return v; }
__device__ __forceinline__ unsigned char* wsptr() { kconst_t* kp = (kconst_t*)__builtin_amdgcn_kernarg_segment_ptr(); asm volatile("" : "+s"(kp)); return *(unsigned char* const __attribute__((address_space(4)))*)(kp + 8 * 18); }
__device__ __forceinline__ float* outptr() { kconst_t* kp = (kconst_t*)__builtin_amdgcn_kernarg_segment_ptr(); asm volatile("" : "+s"(kp)); return *(float* const __attribute__((address_space(4)))*)(kp + 8 * 17); }
__global__ void __launch_bounds__(NWAVES * 64, 2) mk_fwd(Args args) {
    extern __shared__ __attribute__((aligned(16))) unsigned char lds[];
    cg::grid_group grid = cg::this_grid();
    LAS unsigned char* L = (LAS unsigned char*)lds;
    const int tid = threadIdx.x, lane = tid & 63, wave = __builtin_amdgcn_readfirstlane(tid >> 6);
    const int G = gridDim.x, bx = blockIdx.x;
    const int gw = bx * NWAVES + wave, NGW = G * NWAVES;
    const int lo = args.ph_lo, hi = args.ph_hi;
#define IN(k) (lo <= (k) && (k) < hi)
#define SEAM(k) do { if (IN(k) && IN((k) + 1)) grid.sync(); } while (0)

    if (IN(0)) {
        unsigned char* ws = wsptr();
        LAS float* scr = (LAS float*)(L + wave * 16384);
        constexpr int I_IN = 16 * (NIN / 32), I_AO = 8 * 32, I_CO = 16 * 32, I_MO = 16 * 32, I_MI = 16 * 128, I_MO2 = 64 * 32;
        constexpr int NITEMS = I_IN + I_AO + I_CO + I_MO + I_MI + I_MO2;
        for (int it = gw; it < NITEMS; it += NGW) {
            int r = it;
            if (r < I_IN) { p0_transpose_item(inptr(7), 1024, NIN, (bf16*)(ws + WS_WIN), true, scr, r, lane); continue; } r -= I_IN;
            if (r < I_AO) { p0_transpose_item(inptr(10), 512, 1024, (bf16*)(ws + WS_WAO), false, scr, r, lane); continue; } r -= I_AO;
            if (r < I_CO) { p0_transpose_item(inptr(11), 1024, 1024, (bf16*)(ws + WS_WCO), false, scr, r, lane); continue; } r -= I_CO;
            if (r < I_MO) { p0_transpose_item(inptr(12), 1024, 1024, (bf16*)(ws + WS_WMO), false, scr, r, lane); continue; } r -= I_MO;
            if (r < I_MI) { p0_transpose_item(inptr(14), 1024, 4096, (bf16*)(ws + WS_WMI), false, scr, r, lane); continue; } r -= I_MI;
            p0_transpose_item(inptr(15), 4096, 1024, (bf16*)(ws + WS_WMO2), false, scr, r, lane);
        }
        float* rope = (float*)(ws + WS_ROPE);
        for (int i = bx * 512 + tid; i < 16384 * 32; i += G * 512) {
            const int s = i >> 5, j = i & 31;
            const double inv = exp(-(double)j * (9.210340371976184 / 32.0));
            const double rev = (double)s * inv * 0.15915494309189535;
            const float fr = (float)(rev - rint(rev));
            float2 cs; cs.x = __builtin_amdgcn_cosf(fr); cs.y = __builtin_amdgcn_sinf(fr);
            ((float2*)rope)[i] = cs;
        }
        __syncthreads();
        LAS float* red = (LAS float*)L;
        const float *c_p = inptr(2), *c_s = inptr(3), *w_ada = inptr(4), *b_ada = inptr(5); float* mod = (float*)(ws + WS_MOD);
        for (int item = bx; item < 96; item += G) {
            const int e = item * 64 + lane; float a[NB];
#pragma unroll
            for (int b = 0; b < NB; ++b) a[b] = 0.f;
#pragma unroll 4
            for (int k = 128 * wave; k < 128 * wave + 128; ++k) {
                const float wv = w_ada[(size_t)k * 6144 + e];
#pragma unroll
                for (int b = 0; b < NB; ++b) { const float cv = (b < 4) ? c_p[b * 1024 + k] : c_s[(b - 4) * 1024 + k]; a[b] += (cv * sigmoidf_(cv)) * wv; }
            }
#pragma unroll
            for (int b = 0; b < NB; ++b) red[(wave * NB + b) * 64 + lane] = a[b];
            __syncthreads();
            if (wave < NB) { float t = b_ada[e];
#pragma unroll
                for (int w = 0; w < 8; ++w) t += red[(w * NB + wave) * 64 + lane];
                mod[wave * 6144 + e] = t; }
            __syncthreads();
        }
    }
    SEAM(0);
    if (IN(1)) {
        unsigned char* ws = wsptr(); float* out = outptr(); const float* mod = (const float*)(ws + WS_MOD);
        const float *x0 = inptr(0), *x1 = inptr(1), *g1 = inptr(6);
        for (int m = gw; m < MTOT; m += NGW) {
            const int chunk = m >> 14, r = m & (MC - 1); int bi, s, S; rowinfo(chunk, r, bi, s, S);
            const float* xrow = (m < MC) ? x0 + (size_t)m * DM : x1 + (size_t)(m - MC) * DM;
            bf16* xn = (bf16*)(out + (size_t)chunk * MC * DM) + (size_t)r * DM;
            norm_row_bf16(xrow, xn, g1, mod + bi * 6144 + 1024, mod + bi * 6144, lane);
        }
    }
    SEAM(1);
#pragma nounroll
    for (int chunk = 0; chunk < NCHUNK; ++chunk) {
        const int pb = 2 + 8 * chunk;
        if (IN(pb + 0)) {
            unsigned char* ws = wsptr(); float* outc = outptr() + (size_t)chunk * MC * DM;
            pg8::Gemm g{(const pg8::bf16_t*)outc, (const bf16*)(ws + WS_WIN), MC, NIN, DM}; pg8::StaticOrder S; S.init(MC, NIN, opq(G), opq(bx));
            pg8::EpiIn E{chunk, ws};
            pg8::gemm_phase<pg8::EpiIn, pg8::StaticOrder, true, true>(L, g, S, E);
        }
        SEAM(pb + 0);
        if (IN(pb + 1)) {
            unsigned char* ws = wsptr(); int tid_o = tid, lane_o = lane, gw_o = gw; asm volatile("" : "+v"(tid_o), "+v"(lane_o), "+s"(gw_o));
            const bf16 *Ub = (const bf16*)(ws + WS_U), *BGb = (const bf16*)(ws + WS_BG); bf16* CVb = (bf16*)(ws + WS_CVIN);
            const float *conv_w = inptr(8), *conv_b = inptr(9);
            for (int i = bx * 512 + tid_o; i < MC * 128; i += G * 512) {
                const int r = i >> 7, c8 = (i & 127) * 8; int bi, s, S; rowinfo(chunk, r, bi, s, S);
                const v4u uc = *(const v4u*)(Ub + (size_t)r * 1024 + c8);
                v4u up = {0u, 0u, 0u, 0u}, un = {0u, 0u, 0u, 0u};
                if (s > 0) up = *(const v4u*)(Ub + (size_t)(r - 1) * 1024 + c8);
                if (s < S - 1) un = *(const v4u*)(Ub + (size_t)(r + 1) * 1024 + c8);
                const v4u bg = *(const v4u*)(BGb + (size_t)r * 1024 + c8);
                const f32x4 w0a = *(const f32x4*)(conv_w + c8), w0b = *(const f32x4*)(conv_w + c8 + 4);
                const f32x4 w1a = *(const f32x4*)(conv_w + 1024 + c8), w1b = *(const f32x4*)(conv_w + 1024 + c8 + 4);
                const f32x4 w2a = *(const f32x4*)(conv_w + 2048 + c8), w2b = *(const f32x4*)(conv_w + 2048 + c8 + 4);
                const f32x4 cba = *(const f32x4*)(conv_b + c8), cbb = *(const f32x4*)(conv_b + c8 + 4);
                float y[8];
#define CV1(e, UP, UC, UN, BGV, W0, W1, W2, CB) y[e] = (BGV) * ((CB) + (UP) * (W0) + (UC) * (W1) + (UN) * (W2))
                CV1(0, bflo(up.x), bflo(uc.x), bflo(un.x), bflo(bg.x), w0a[0], w1a[0], w2a[0], cba[0]);
                CV1(1, bfhi(up.x), bfhi(uc.x), bfhi(un.x), bfhi(bg.x), w0a[1], w1a[1], w2a[1], cba[1]);
                CV1(2, bflo(up.y), bflo(uc.y), bflo(un.y), bflo(bg.y), w0a[2], w1a[2], w2a[2], cba[2]);
                CV1(3, bfhi(up.y), bfhi(uc.y), bfhi(un.y), bfhi(bg.y), w0a[3], w1a[3], w2a[3], cba[3]);
                CV1(4, bflo(up.z), bflo(uc.z), bflo(un.z), bflo(bg.z), w0b[0], w1b[0], w2b[0], cbb[0]);
                CV1(5, bfhi(up.z), bfhi(uc.z), bfhi(un.z), bfhi(bg.z), w0b[1], w1b[1], w2b[1], cbb[1]);
                CV1(6, bflo(up.w), bflo(uc.w), bflo(un.w), bflo(bg.w), w0b[2], w1b[2], w2b[2], cbb[2]);
                CV1(7, bfhi(up.w), bfhi(uc.w), bfhi(un.w), bfhi(bg.w), w0b[3], w1b[3], w2b[3], cbb[3]);
#undef CV1
                v4u o; o.x = pkbf(y[0], y[1]); o.y = pkbf(y[2], y[3]); o.z = pkbf(y[4], y[5]); o.w = pkbf(y[6], y[7]);
                *(v4u*)(CVb + (size_t)r * 1024 + c8) = o;
            }
            __syncthreads();
            for (int u = opq(bx); u < 1536; u += G) attn_unit(L, ws, chunk, u, lane_o, wave);
        }
        SEAM(pb + 1);
        if (IN(pb + 2)) {
            unsigned char* ws = wsptr(); int tid_o = tid; asm volatile("" : "+v"(tid_o));
            const float* LSE = (const float*)(ws + WS_LSE); const bf16* Ob = (const bf16*)(ws + WS_Q); bf16* ATTb = (bf16*)(ws + WS_ATT);
            for (int i = bx * 512 + tid_o; i < MC * 64; i += G * 512) {
                const int row = i >> 6, hh = (i >> 3) & 7, c8 = i & 7;
                const float l0 = LSE[row * 24 + hh], l1 = LSE[row * 24 + 8 + hh], l2 = LSE[row * 24 + 16 + hh];
                const float mx = fmaxf(l0, fmaxf(l1, l2));
                float w0 = __builtin_amdgcn_exp2f(l0 - mx), w1 = __builtin_amdgcn_exp2f(l1 - mx), w2 = __builtin_amdgcn_exp2f(l2 - mx);
                const float inv = 1.f / (w0 + w1 + w2); w0 *= inv; w1 *= inv; w2 *= inv;
                const bf16* op = Ob + (size_t)row * QW + hh * 64 + c8 * 8;
                const v4u a = *(const v4u*)op, bq = *(const v4u*)(op + 512), c = *(const v4u*)(op + 1024);
                v4u o;
                o.x = pkbf(w0 * bflo(a.x) + w1 * bflo(bq.x) + w2 * bflo(c.x), w0 * bfhi(a.x) + w1 * bfhi(bq.x) + w2 * bfhi(c.x));
                o.y = pkbf(w0 * bflo(a.y) + w1 * bflo(bq.y) + w2 * bflo(c.y), w0 * bfhi(a.y) + w1 * bfhi(bq.y) + w2 * bfhi(c.y));
                o.z = pkbf(w0 * bflo(a.z) + w1 * bflo(bq.z) + w2 * bflo(c.z), w0 * bfhi(a.z) + w1 * bfhi(bq.z) + w2 * bfhi(c.z));
                o.w = pkbf(w0 * bflo(a.w) + w1 * bflo(bq.w) + w2 * bflo(c.w), w0 * bfhi(a.w) + w1 * bfhi(bq.w) + w2 * bfhi(c.w));
                *(v4u*)(ATTb + (size_t)row * ATTO + hh * 64 + c8 * 8) = o;
            }
            pg8::Gemm g{(const bf16*)(ws + WS_CVIN), (const bf16*)(ws + WS_WCO), MC, DM, DM}; pg8::StaticOrder S; S.init(MC, DM, opq(G), opq(bx));
            pg8::EpiGate<0> E{(bf16*)(ws + WS_T1), (const bf16*)(ws + WS_GC), nullptr, 1024};
            pg8::gemm_phase<pg8::EpiGate<0>, pg8::StaticOrder, true, true>(L, g, S, E);
        }
        SEAM(pb + 2);
        if (IN(pb + 3)) {
            unsigned char* ws = wsptr();
            pg8::Gemm g{(const bf16*)(ws + WS_ATT), (const bf16*)(ws + WS_WAO), MC, DM, ATTO}; pg8::StaticOrder S; S.init(MC, DM, opq(G), opq(bx));
            pg8::EpiGate<1> E{(bf16*)(ws + WS_MRG), (const bf16*)(ws + WS_GA), (const bf16*)(ws + WS_T1), 1024};
            pg8::gemm_phase<pg8::EpiGate<1>, pg8::StaticOrder, true, true>(L, g, S, E);
        }
        SEAM(pb + 3);
        if (IN(pb + 4)) {
            unsigned char* ws = wsptr(); float* outc = outptr() + (size_t)chunk * MC * DM;
            const float* xc = (chunk == 0) ? inptr(0) : inptr(1) + (size_t)(chunk - 1) * MC * DM;
            pg8::Gemm g{(const bf16*)(ws + WS_MRG), (const bf16*)(ws + WS_WMO), MC, DM, DM}; pg8::StaticOrder S; S.init(MC, DM, opq(G), opq(bx));
            pg8::EpiRes E{xc, outc, (const float*)(ws + WS_MOD) + 2048, chunk};
            pg8::gemm_phase<pg8::EpiRes, pg8::StaticOrder, true, true>(L, g, S, E);
        }
        SEAM(pb + 4);
        if (IN(pb + 5)) {
            int lane_o = lane, gw_o = gw; asm volatile("" : "+v"(lane_o), "+s"(gw_o));
            unsigned char* ws = wsptr(); float* outc = outptr() + (size_t)chunk * MC * DM; const float* mod = (const float*)(ws + WS_MOD); const float* g2 = inptr(13);
            bf16* XN2b = (bf16*)(ws + WS_XN2);
            for (int r = gw_o; r < MC; r += NGW) { int bi, s, S; rowinfo(chunk, r, bi, s, S);
                norm_row_bf16(outc + (size_t)r * DM, XN2b + (size_t)r * DM, g2, mod + bi * 6144 + 4096, mod + bi * 6144 + 3072, lane_o); }
        }
        SEAM(pb + 5);
        if (IN(pb + 6)) {
            unsigned char* ws = wsptr();
            pg8::Gemm g{(const bf16*)(ws + WS_XN2), (const bf16*)(ws + WS_WMI), MC, DFF, DM}; pg8::StaticOrder S; S.init(MC, DFF, opq(G), opq(bx));
            pg8::EpiGate<2> E{(bf16*)(ws + WS_HDN), nullptr, nullptr, DFF};
            pg8::gemm_phase<pg8::EpiGate<2>, pg8::StaticOrder, true, true>(L, g, S, E);
        }
        SEAM(pb + 6);
        if (IN(pb + 7)) {
            unsigned char* ws = wsptr(); float* outc = outptr() + (size_t)chunk * MC * DM;
            pg8::Gemm g{(const bf16*)(ws + WS_HDN), (const bf16*)(ws + WS_WMO2), MC, DM, DFF}; pg8::StaticOrder S; S.init(MC, DM, opq(G), opq(bx));
            pg8::EpiRes E{outc, outc, (const float*)(ws + WS_MOD) + 5120, chunk};
            pg8::gemm_phase<pg8::EpiRes, pg8::StaticOrder, true, true>(L, g, S, E);
        }
        SEAM(pb + 7);
    }
    if (IN(NPHASE - 1)) {
        float* out = outptr(); const float* gf = inptr(16);
        for (int m = gw; m < MTOT; m += NGW) norm_row_f32(out + (size_t)m * DM, gf, lane);
    }
#undef IN
#undef SEAM
}

#ifndef MK_N_LAUNCHES
#define MK_N_LAUNCHES 1
#endif
extern "C" void kernel_launch(void* const* d_in, const int* in_sizes, int n_in, void* d_out, int out_size, void* d_ws, size_t ws_size, hipStream_t stream) {
    static int grid = 0;
    if (grid == 0) {
        if (n_in != 17 || out_size != MTOT * DM || ws_size < WS_END) { fprintf(stderr, "kernel_launch: unexpected shapes (n_in %d out %d ws %zu)\n", n_in, out_size, ws_size); grid = -1; return; }
        int dev = 0, cus = 0, per_cu = 0;
        if (hipGetDevice(&dev) != hipSuccess || hipDeviceGetAttribute(&cus, hipDeviceAttributeMultiprocessorCount, dev) != hipSuccess) { grid = -1; return; }
        if (hipFuncSetAttribute((const void*)mk_fwd, hipFuncAttributeMaxDynamicSharedMemorySize, LDS_BYTES) != hipSuccess) { fprintf(stderr, "kernel_launch: hipFuncSetAttribute failed\n"); grid = -1; return; }
        if (hipOccupancyMaxActiveBlocksPerMultiprocessor(&per_cu, (const void*)mk_fwd, NWAVES * 64, LDS_BYTES) != hipSuccess || per_cu < 1) { fprintf(stderr, "kernel_launch: occupancy query says %d\n", per_cu); (void)hipGetLastError(); per_cu = 1; }
        if (per_cu > 1) per_cu = 1;
        grid = cus * per_cu;
    }
    if (grid < 0) return;
    Args a{};
    for (int i = 0; i < 17; ++i) a.in[i] = (const float*)d_in[i];
    a.out = (float*)d_out; a.ws = (unsigned char*)d_ws;
    if (MK_N_LAUNCHES == 1) {
        a.ph_lo = 0; a.ph_hi = NPHASE;
        void* kargs[] = {&a};
        hipError_t e = hipLaunchCooperativeKernel((const void*)mk_fwd, dim3(grid), dim3(NWAVES * 64), kargs, LDS_BYTES, stream);
        if (e != hipSuccess) fprintf(stderr, "cooperative launch failed: %s (grid %d)\n", hipGetErrorString(e), grid);
    } else {
        for (int p = 0; p < NPHASE; ++p) { a.ph_lo = p; a.ph_hi = p + 1; hipLaunchKernelGGL(mk_fwd, dim3(grid), dim3(NWAVES * 64), LDS_BYTES, stream, a); }
    }
}
```

```cpp
#include <hip/hip_runtime.h>
#include <hip/hip_cooperative_groups.h>
#include <cstdio>
#include <cstdint>
namespace cg = cooperative_groups;
namespace pg8 {
#define PG8_LAS __attribute__((address_space(3)))
typedef unsigned short bf16_t;
typedef short bf16x8 __attribute__((ext_vector_type(8)));
typedef float f32x4 __attribute__((ext_vector_type(4)));
typedef unsigned u32x4 __attribute__((ext_vector_type(4)));
constexpr int BM = 256, BK = 64, HALF = 128, HTB = HALF * BK * 2  , STAGE_BYTES = 8 * HTB, NXCD = 8, WGM = 8;

__host__ __device__ __forceinline__ int lds_byte(int r, int c) { const int st = (r >> 4) * 2 + (c >> 5), rr = r & 15, cc = c & 31, ob = rr * 64 + cc * 2; return st * 1024 + (ob ^ (((ob >> 9) & 1) << 5)); }
__host__ __device__ __forceinline__ void stage_rc(int b, int& R, int& C) { const int st = b / 1024, sb = b % 1024, swz = sb ^ (((sb >> 9) & 1) << 5); R = (st >> 1) * 16 + swz / 64; C = (st & 1) * 32 + (swz % 64) / 2; }
__host__ __device__ __forceinline__ int perm32(int rho) { const int n = rho >> 4, i = rho & 15; return 8 * (i >> 2) + 4 * n + (i & 3); }

struct Unit { int pm, pn; };
struct Gemm { const bf16_t* A; const bf16_t* Bt; int M, N, K; };

struct StaticOrder {
    int nM, nN, nwg, G, c;
    __host__ __device__ void init(int M, int N, int G_, int c_) { nM = M / BM; nN = N / BM; nwg = nM * nN; G = G_; c = c_; }
    __host__ __device__ bool next(int i, Unit& u) const {
        const long L = (long)i * G + c; if (L >= nwg) return false;
        int wgid = (int)L; { const int q = nwg / NXCD, r = nwg % NXCD, xcd = wgid % NXCD, off = wgid / NXCD; wgid = (xcd < r ? xcd * (q + 1) : r * (q + 1) + (xcd - r) * q) + off; }
        const int nig = WGM * nN, gid = wgid / nig, fm = gid * WGM, gsz = (nM - fm) < WGM ? (nM - fm) : WGM;
        u.pm = fm + ((wgid % nig) % gsz); u.pn = (wgid % nig) / gsz; return true;
    }
    __device__ __forceinline__ void a_ready(const Unit&) const {}
    __device__ __forceinline__ void done(const Unit&) const {}
};

__device__ __forceinline__ unsigned cvt_pk_bf16(float lo, float hi) { unsigned r; asm volatile("v_cvt_pk_bf16_f32 %0, %1, %2" : "=v"(r) : "v"(lo), "v"(hi)); return r; }
typedef float f32x2 __attribute__((ext_vector_type(2)));
template <class Epi, class Sched, bool ALIGN_EPI = false, bool SP2 = false>
__device__ __forceinline__ void gemm_phase(PG8_LAS unsigned char* lds, const Gemm g, const Sched& S, const Epi& E) {
    int tid_ = threadIdx.x; asm volatile("" : "+v"(tid_));
    const int tid = tid_, wid = __builtin_amdgcn_readfirstlane(tid >> 6), lane = tid & 63, wr = wid >> 2, wc = wid & 3, fr = lane & 15, fq = lane >> 4;
    const int K = g.K, nt = K / BK;
    unsigned voffA[2], voffB[2];
#pragma unroll
    for (int i = 0; i < 2; ++i) { int R, C; stage_rc(tid * 16 + i * 8192, R, C); const int Rb = Epi::PERM ? ((R & ~31) + perm32(R & 31)) : R;
        voffA[i] = (unsigned)(R * K + C) * 2u; voffB[i] = (unsigned)(Rb * K + C) * 2u; }
    const size_t kstep = (size_t)(BK * 2);
    const size_t hstep = (size_t)HALF * K * 2;
    const size_t tstep = 2 * hstep;
    const unsigned ldsw = (unsigned)wid * 1024u;
    const int aoff = lds_byte(wr * 64 + fr, fq * 8), boff = lds_byte(wc * 32 + fr, fq * 8);
#define PG8_SA(b, h) (((b) * 2 + (h)) * HTB)
#define PG8_SB(b, h) ((4 + (b) * 2 + (h)) * HTB)
#define PG8_STAGE(bufoff, gbase, voff) do { _Pragma("unroll") for (int _i = 0; _i < 2; ++_i) \
        __builtin_amdgcn_global_load_lds((const unsigned*)((const char*)(gbase) + (voff)[_i]), (PG8_LAS unsigned*)(lds + (bufoff) + ldsw + _i * 8192), 16, 0, 0); } while (0)
#define PG8_LDA(dst, b, h) do { _Pragma("unroll") for (int m = 0; m < 4; ++m) _Pragma("unroll") for (int k = 0; k < 2; ++k) dst[m][k] = *(const PG8_LAS bf16x8*)(lds + PG8_SA(b, h) + aoff + m * 2048 + k * 1024); } while (0)
#define PG8_LDB(dst, b, h) do { _Pragma("unroll") for (int n = 0; n < 2; ++n) _Pragma("unroll") for (int k = 0; k < 2; ++k) dst[n][k] = *(const PG8_LAS bf16x8*)(lds + PG8_SB(b, h) + boff + n * 2048 + k * 1024); } while (0)
#define PG8_MMA(ai, bj, At, Bt) do { __builtin_amdgcn_s_setprio(1); _Pragma("unroll") for (int m = 0; m < 4; ++m) _Pragma("unroll") for (int n = 0; n < 2; ++n) _Pragma("unroll") for (int k = 0; k < 2; ++k) \
        acc[ai][bj][m][n] = __builtin_amdgcn_mfma_f32_16x16x32_bf16(Bt[n][k], At[m][k], acc[ai][bj][m][n], 0, 0, 0); __builtin_amdgcn_s_setprio(0); } while (0)
#define PG8_WAIT_V(n) asm volatile("s_waitcnt vmcnt(" #n ")" ::: "memory")
#define PG8_WAIT_L(n) asm volatile("s_waitcnt lgkmcnt(" #n ")" ::: "memory")
#define PG8_BAR __builtin_amdgcn_s_barrier()
#define PG8_SCHED __builtin_amdgcn_sched_barrier(0)
    Unit cur, nxt; int ui = 0;
    if (!S.next(0, cur)) return;
    f32x4 acc[2][2][4][2];
#pragma unroll
    for (int a = 0; a < 2; ++a)
#pragma unroll
        for (int b = 0; b < 2; ++b)
#pragma unroll
            for (int m = 0; m < 4; ++m)
#pragma unroll
                for (int n = 0; n < 2; ++n) acc[a][b][m][n] = (f32x4){0.f, 0.f, 0.f, 0.f};
    bf16x8 At[4][2], B0[2][2], B1[2][2];
    const char* cA = (const char*)g.A + (size_t)cur.pm * tstep; const char* cB = (const char*)g.Bt + (size_t)cur.pn * tstep;
    S.a_ready(cur);
    if constexpr (SP2) {
        PG8_STAGE(PG8_SB(0, 0), cB, voffB); PG8_STAGE(PG8_SB(0, 1), cB + hstep, voffB); PG8_STAGE(PG8_SA(0, 0), cA, voffA); PG8_STAGE(PG8_SA(0, 1), cA + hstep, voffA);
        if (wr == 1) PG8_BAR;
        PG8_WAIT_V(2); PG8_BAR;
        PG8_STAGE(PG8_SB(1, 0), cB + kstep, voffB); PG8_STAGE(PG8_SA(1, 0), cA + kstep, voffA); PG8_STAGE(PG8_SB(1, 1), cB + hstep + kstep, voffB);
        PG8_WAIT_V(6); PG8_BAR;
    } else {
        PG8_STAGE(PG8_SB(0, 0), cB, voffB); PG8_STAGE(PG8_SA(0, 0), cA, voffA); PG8_STAGE(PG8_SB(0, 1), cB + hstep, voffB); PG8_STAGE(PG8_SA(0, 1), cA + hstep, voffA);
        if (wr == 1) PG8_BAR;
        PG8_WAIT_V(4); PG8_BAR;
        PG8_STAGE(PG8_SB(1, 0), cB + kstep, voffB); PG8_STAGE(PG8_SA(1, 0), cA + kstep, voffA); PG8_STAGE(PG8_SB(1, 1), cB + hstep + kstep, voffB);
        PG8_WAIT_V(6); PG8_BAR;
    }
    for (;;) {
        const bool has_next = S.next(ui + 1, nxt);
        const char* nA = has_next ? (const char*)g.A + (size_t)nxt.pm * tstep : cA; const char* nB = has_next ? (const char*)g.Bt + (size_t)nxt.pn * tstep : cB;
        for (int t = 0; t < nt; t += 2) {
            const bool last = (t == nt - 2);
            const char* a1 = cA + (size_t)(t + 1) * kstep;
            const char* a2 = last ? nA : cA + (size_t)(t + 2) * kstep; const char* b2 = last ? nB : cB + (size_t)(t + 2) * kstep;
            const char* a3 = a2 + kstep; const char* b3 = b2 + kstep;
            if (last && has_next) S.a_ready(nxt);
            if constexpr (SP2) {
            PG8_LDB(B0, 0, 0); PG8_LDB(B1, 0, 1); PG8_SCHED; PG8_LDA(At, 0, 0); PG8_STAGE(PG8_SA(1, 1), a1 + hstep, voffA);
            PG8_WAIT_V(8); PG8_WAIT_L(0); PG8_BAR; PG8_MMA(0, 0, At, B0); PG8_MMA(0, 1, At, B1); PG8_BAR; PG8_SCHED;
            PG8_LDA(At, 0, 1); PG8_STAGE(PG8_SB(0, 0), b2, voffB); PG8_STAGE(PG8_SB(0, 1), b2 + hstep, voffB); PG8_STAGE(PG8_SA(0, 0), a2, voffA);
            PG8_WAIT_V(8); PG8_WAIT_L(0); PG8_BAR; PG8_MMA(1, 0, At, B0); PG8_MMA(1, 1, At, B1); PG8_BAR; PG8_SCHED;
            PG8_LDB(B0, 1, 0); PG8_LDB(B1, 1, 1); PG8_SCHED; PG8_LDA(At, 1, 0); PG8_STAGE(PG8_SA(0, 1), a2 + hstep, voffA);
            PG8_WAIT_V(8); PG8_WAIT_L(0); PG8_BAR; PG8_MMA(0, 0, At, B0); PG8_MMA(0, 1, At, B1); PG8_BAR; PG8_SCHED;
            PG8_LDA(At, 1, 1); PG8_STAGE(PG8_SB(1, 0), b3, voffB); PG8_STAGE(PG8_SB(1, 1), b3 + hstep, voffB); PG8_STAGE(PG8_SA(1, 0), a3, voffA);
            PG8_WAIT_V(8); PG8_WAIT_L(0); PG8_BAR; PG8_MMA(1, 0, At, B0); PG8_MMA(1, 1, At, B1); PG8_BAR; PG8_SCHED;
            } else {
            PG8_LDB(B0, 0, 0); PG8_SCHED; PG8_LDA(At, 0, 0); PG8_STAGE(PG8_SA(1, 1), a1 + hstep, voffA);
            PG8_WAIT_L(8); PG8_BAR; PG8_WAIT_L(0); PG8_MMA(0, 0, At, B0); PG8_BAR; PG8_SCHED;
            PG8_LDB(B1, 0, 1); PG8_STAGE(PG8_SB(0, 0), b2, voffB);
            PG8_BAR; PG8_WAIT_L(0); PG8_MMA(0, 1, At, B1); PG8_BAR;
            PG8_LDA(At, 0, 1); PG8_STAGE(PG8_SA(0, 0), a2, voffA);
            PG8_BAR; PG8_WAIT_L(0); PG8_MMA(1, 0, At, B0); PG8_BAR; PG8_SCHED;
            PG8_STAGE(PG8_SB(0, 1), b2 + hstep, voffB);
            PG8_WAIT_V(6); PG8_BAR; PG8_MMA(1, 1, At, B1); PG8_BAR;
            PG8_LDB(B0, 1, 0); PG8_SCHED; PG8_LDA(At, 1, 0); PG8_STAGE(PG8_SA(0, 1), a2 + hstep, voffA);
            PG8_WAIT_L(8); PG8_BAR; PG8_WAIT_L(0); PG8_MMA(0, 0, At, B0); PG8_BAR; PG8_SCHED;
            PG8_LDB(B1, 1, 1); PG8_STAGE(PG8_SB(1, 0), b3, voffB);
            PG8_BAR; PG8_WAIT_L(0); PG8_MMA(0, 1, At, B1); PG8_BAR;
            PG8_LDA(At, 1, 1); PG8_STAGE(PG8_SA(1, 0), a3, voffA);
            PG8_BAR; PG8_WAIT_L(0); PG8_MMA(1, 0, At, B0); PG8_BAR; PG8_SCHED;
            PG8_STAGE(PG8_SB(1, 1), b3 + hstep, voffB);
            PG8_WAIT_V(6); PG8_BAR; PG8_MMA(1, 1, At, B1); PG8_BAR;
            }
        }
        if constexpr (ALIGN_EPI) { if (wr == 0) PG8_BAR; }
        if constexpr (!Epi::AFTER_DRAIN) { E(acc, cur, wr, wc, fr, fq); S.done(cur); }
        if (!has_next) break;
#pragma unroll
        for (int a = 0; a < 2; ++a)
#pragma unroll
            for (int b = 0; b < 2; ++b)
#pragma unroll
                for (int m = 0; m < 4; ++m)
#pragma unroll
                    for (int n = 0; n < 2; ++n) acc[a][b][m][n] = (f32x4){0.f, 0.f, 0.f, 0.f};
        cur = nxt; cA = nA; cB = nB; ++ui;
        if constexpr (ALIGN_EPI) { if (wr == 1) PG8_BAR; }
    }
    PG8_WAIT_V(0);
    if constexpr (!ALIGN_EPI) { if (wr == 0) PG8_BAR; }
    PG8_BAR;
    if constexpr (Epi::AFTER_DRAIN) { E.fused(acc, cur, wr, wc, fr, fq, lds, wid, lane); S.done(cur); }
#undef PG8_SA
#undef PG8_SB
#undef PG8_STAGE
#undef PG8_LDA
#undef PG8_LDB
#undef PG8_MMA
#undef PG8_WAIT_V
#undef PG8_WAIT_L
#undef PG8_BAR
#undef PG8_SCHED
}
}

#define GAS __attribute__((address_space(1)))
#define LAS __attribute__((address_space(3)))
typedef unsigned short bf16;
typedef unsigned v4u __attribute__((ext_vector_type(4)));
typedef unsigned v2u __attribute__((ext_vector_type(2)));
typedef float f32x4 __attribute__((ext_vector_type(4)));
constexpr int DM = 1024, MTOT = 49152, MC = 16384, NCHUNK = 3, NB = 6;
constexpr int NIN = 9728, DFF = 4096, QW = 1536, ATTO = 512;
constexpr float EPS = 1e-6f;
constexpr float QSCALE = 0.125f * 1.4426950408889634f;
constexpr int NWAVES = 8;
constexpr size_t MiB = 1u << 20;
constexpr size_t WS_MOD = 1 * MiB, WS_ROPE = 2 * MiB, WS_WIN = 6 * MiB, WS_WAO = 25 * MiB, WS_WCO = 26 * MiB, WS_WMO = 28 * MiB, WS_WMI = 30 * MiB, WS_WMO2 = 38 * MiB;
constexpr size_t WS_Q = 48 * MiB, WS_K = 96 * MiB, WS_V = 144 * MiB, WS_U = 192 * MiB, WS_BG = 224 * MiB, WS_GA = 256 * MiB, WS_GC = 288 * MiB;
constexpr size_t WS_ATT = 320 * MiB, WS_CVIN = 336 * MiB, WS_T1 = 368 * MiB, WS_MRG = 400 * MiB, WS_XN2 = 432 * MiB, WS_END = 464 * MiB;
constexpr size_t WS_LSE = 46 * MiB;
constexpr size_t WS_HDN = 48 * MiB;
constexpr int LDS_BYTES = 147456;

__device__ __forceinline__ unsigned pkbf(float lo, float hi) { unsigned r; asm volatile("v_cvt_pk_bf16_f32 %0, %1, %2" : "=v"(r) : "v"(lo), "v"(hi)); return r; }
__device__ __forceinline__ float bflo(unsigned u) { return __builtin_bit_cast(float, u << 16); }
__device__ __forceinline__ float bfhi(unsigned u) { return __builtin_bit_cast(float, u & 0xffff0000u); }
__device__ __forceinline__ float wave_sum(float v) {
#pragma unroll
    for (int o = 1; o < 64; o <<= 1) v += __shfl_xor(v, o);
    return v;
}
__device__ __forceinline__ float wave_max(float v) {
#pragma unroll
    for (int o = 1; o < 64; o <<= 1) v = fmaxf(v, __shfl_xor(v, o));
    return v;
}
__device__ __forceinline__ float sigmoidf_(float x) { return __builtin_amdgcn_rcpf(1.f + __expf(-x)); }
__device__ __forceinline__ void rowinfo(int chunk, int r, int& bi, int& s, int& S) { if (chunk == 0) { bi = r >> 12; s = r & 4095; S = 4096; } else { bi = 3 + chunk; s = r; S = 16384; } }

namespace pg8 {
struct EpiIn {
    static constexpr bool PERM = true, AFTER_DRAIN = false;
    int chunk; unsigned char* ws;
    __device__ __forceinline__ void operator()(const f32x4 (&acc)[2][2][4][2], const Unit& u, int wr, int wc, int fr, int fq) const {
        const int pn = u.pn; const int row0 = u.pm * BM + wr * 64 + fr;
        bf16_t* const Q = (bf16_t*)(ws + WS_Q); bf16_t* const K = (bf16_t*)(ws + WS_K); bf16_t* const V = (bf16_t*)(ws + WS_V); bf16_t* const U = (bf16_t*)(ws + WS_U);
        bf16_t* const BG = (bf16_t*)(ws + WS_BG); bf16_t* const GA = (bf16_t*)(ws + WS_GA); bf16_t* const GC = (bf16_t*)(ws + WS_GC); const float* const rope = (const float*)(ws + WS_ROPE);
        if (pn < 12) {
            bf16_t* base = (pn < 6) ? Q : K; const int hd = 4 * (pn < 6 ? pn : pn - 6) + wc; const float sc = (pn < 6) ? QSCALE : 1.f;
#pragma unroll
            for (int ai = 0; ai < 2; ++ai)
#pragma unroll
                for (int m = 0; m < 4; ++m) {
                    const int row = row0 + ai * HALF + m * 16; const int s = (chunk == 0) ? (row & 4095) : row;
                    const f32x4* rp = (const f32x4*)(rope + (size_t)s * 64 + 16 * fq);
                    const f32x4 c0 = rp[0], c1 = rp[1], c2 = rp[2], c3 = rp[3];
                    const f32x4 a0 = acc[ai][0][m][0], a1 = acc[ai][0][m][1], b0 = acc[ai][1][m][0], b1 = acc[ai][1][m][1];
                    u32x4 w1, w2;
                    w1.x = cvt_pk_bf16((a0[0] * c0[0] - b0[0] * c0[1]) * sc, (a0[1] * c0[2] - b0[1] * c0[3]) * sc);
                    w1.y = cvt_pk_bf16((a0[2] * c1[0] - b0[2] * c1[1]) * sc, (a0[3] * c1[2] - b0[3] * c1[3]) * sc);
                    w1.z = cvt_pk_bf16((a1[0] * c2[0] - b1[0] * c2[1]) * sc, (a1[1] * c2[2] - b1[1] * c2[3]) * sc);
                    w1.w = cvt_pk_bf16((a1[2] * c3[0] - b1[2] * c3[1]) * sc, (a1[3] * c3[2] - b1[3] * c3[3]) * sc);
                    w2.x = cvt_pk_bf16((b0[0] * c0[0] + a0[0] * c0[1]) * sc, (b0[1] * c0[2] + a0[1] * c0[3]) * sc);
                    w2.y = cvt_pk_bf16((b0[2] * c1[0] + a0[2] * c1[1]) * sc, (b0[3] * c1[2] + a0[3] * c1[3]) * sc);
                    w2.z = cvt_pk_bf16((b1[0] * c2[0] + a1[0] * c2[1]) * sc, (b1[1] * c2[2] + a1[1] * c2[3]) * sc);
                    w2.w = cvt_pk_bf16((b1[2] * c3[0] + a1[2] * c3[1]) * sc, (b1[3] * c3[2] + a1[3] * c3[3]) * sc);
                    bf16_t* p = base + (size_t)row * 1536 + hd * 64 + 8 * fq;
                    *(u32x4*)p = w1; *(u32x4*)(p + 32) = w2;
                }
        } else if (pn < 18) {
#pragma unroll
            for (int ai = 0; ai < 2; ++ai)
#pragma unroll
                for (int m = 0; m < 4; ++m)
#pragma unroll
                    for (int bj = 0; bj < 2; ++bj) {
                        const int row = row0 + ai * HALF + m * 16; const f32x4 v0 = acc[ai][bj][m][0], v1 = acc[ai][bj][m][1];
                        u32x4 w; w.x = cvt_pk_bf16(v0[0], v0[1]); w.y = cvt_pk_bf16(v0[2], v0[3]); w.z = cvt_pk_bf16(v1[0], v1[1]); w.w = cvt_pk_bf16(v1[2], v1[3]);
                        *(u32x4*)(V + (size_t)row * 1536 + (pn - 12) * 256 + bj * HALF + wc * 32 + 8 * fq) = w;
                    }
        } else if (pn < 26) {
#pragma unroll
            for (int ai = 0; ai < 2; ++ai)
#pragma unroll
                for (int m = 0; m < 4; ++m) {
                    const int row = row0 + ai * HALF + m * 16; const f32x4 v0 = acc[ai][0][m][0] * acc[ai][1][m][0], v1 = acc[ai][0][m][1] * acc[ai][1][m][1];
                    u32x4 w; w.x = cvt_pk_bf16(v0[0], v0[1]); w.y = cvt_pk_bf16(v0[2], v0[3]); w.z = cvt_pk_bf16(v1[0], v1[1]); w.w = cvt_pk_bf16(v1[2], v1[3]);
                    *(u32x4*)(U + (size_t)row * 1024 + (pn - 18) * 128 + wc * 32 + 8 * fq) = w;
                }
        } else {
            bf16_t* base = (pn < 30) ? BG : (pn < 34) ? GA : GC; const int ct = (pn < 30) ? pn - 26 : (pn < 34) ? pn - 30 : pn - 34; const bool sg = pn >= 30;
#pragma unroll
            for (int ai = 0; ai < 2; ++ai)
#pragma unroll
                for (int m = 0; m < 4; ++m)
#pragma unroll
                    for (int bj = 0; bj < 2; ++bj) {
                        const int row = row0 + ai * HALF + m * 16; f32x4 v0 = acc[ai][bj][m][0], v1 = acc[ai][bj][m][1];
                        if (sg) {
#pragma unroll
                            for (int e = 0; e < 4; ++e) { v0[e] = sigmoidf_(v0[e]); v1[e] = sigmoidf_(v1[e]); } }
                        u32x4 w; w.x = cvt_pk_bf16(v0[0], v0[1]); w.y = cvt_pk_bf16(v0[2], v0[3]); w.z = cvt_pk_bf16(v1[0], v1[1]); w.w = cvt_pk_bf16(v1[2], v1[3]);
                        *(u32x4*)(base + (size_t)row * 1024 + ct * 256 + bj * HALF + wc * 32 + 8 * fq) = w;
                    }
        }
    }
};
template <int MODE> struct EpiGate {
    static constexpr bool PERM = true, AFTER_DRAIN = false;
    bf16_t* O; const bf16_t* G; const bf16_t* ADD; int ldc;
    __device__ __forceinline__ void operator()(const f32x4 (&acc)[2][2][4][2], const Unit& u, int wr, int wc, int fr, int fq) const {
        const int row0 = u.pm * BM + wr * 64 + fr, col0 = u.pn * BM + wc * 32 + 8 * fq;
#pragma unroll
        for (int ai = 0; ai < 2; ++ai)
#pragma unroll
            for (int m = 0; m < 4; ++m)
#pragma unroll
                for (int bj = 0; bj < 2; ++bj) {
                    const size_t idx = (size_t)(row0 + ai * HALF + m * 16) * ldc + col0 + bj * HALF;
                    f32x4 v0 = acc[ai][bj][m][0], v1 = acc[ai][bj][m][1];
                    if (MODE == 2) {
#pragma unroll
                        for (int e = 0; e < 4; ++e) { const float a = fmaxf(v0[e], 0.f), b = fmaxf(v1[e], 0.f); v0[e] = a * a; v1[e] = b * b; }
                    } else {
                        const u32x4 g = *(const u32x4*)(G + idx);
                        v0[0] *= bflo(g.x); v0[1] *= bfhi(g.x); v0[2] *= bflo(g.y); v0[3] *= bfhi(g.y); v1[0] *= bflo(g.z); v1[1] *= bfhi(g.z); v1[2] *= bflo(g.w); v1[3] *= bfhi(g.w);
                        if (MODE == 1) { const u32x4 t = *(const u32x4*)(ADD + idx);
                            v0[0] += bflo(t.x); v0[1] += bfhi(t.x); v0[2] += bflo(t.y); v0[3] += bfhi(t.y); v1[0] += bflo(t.z); v1[1] += bfhi(t.z); v1[2] += bflo(t.w); v1[3] += bfhi(t.w); }
                    }
                    u32x4 w; w.x = cvt_pk_bf16(v0[0], v0[1]); w.y = cvt_pk_bf16(v0[2], v0[3]); w.z = cvt_pk_bf16(v1[0], v1[1]); w.w = cvt_pk_bf16(v1[2], v1[3]);
                    *(u32x4*)(O + idx) = w;
                }
    }
};
struct EpiRes {
    static constexpr bool PERM = false, AFTER_DRAIN = false;
    const float* base; float* out; const float* gt0; int chunk;
    __device__ __forceinline__ void operator()(const f32x4 (&acc)[2][2][4][2], const Unit& u, int wr, int wc, int fr, int fq) const {
        const int row0 = u.pm * BM + wr * 64 + fr, col0 = u.pn * BM + wc * 32 + 4 * fq;
        const int bi = (chunk == 0) ? ((u.pm * BM) >> 12) : 3 + chunk;
        const float* gt = gt0 + bi * 6144;
#pragma unroll
        for (int bj = 0; bj < 2; ++bj)
#pragma unroll
            for (int n = 0; n < 2; ++n) {
                const int col = col0 + bj * HALF + n * 16; const f32x4 g = *(const f32x4*)(gt + col);
#pragma unroll
                for (int ai = 0; ai < 2; ++ai)
#pragma unroll
                    for (int m = 0; m < 4; ++m) { const size_t idx = (size_t)(row0 + ai * HALF + m * 16) * 1024 + col;
                        const f32x4 b = *(const f32x4*)(base + idx); *(f32x4*)(out + idx) = b + g * acc[ai][bj][m][n]; }
            }
    }
};
}

struct Args { const float* in[17]; float* out; unsigned char* ws; int ph_lo, ph_hi; };

__device__ __forceinline__ int win_dst_row(int n0) {
    if (n0 < 3072) { const int tile = n0 >> 8, sb = (n0 >> 5) & 7, hd = sb >> 1, half = sb & 1; return (tile << 8) + ((4 * half + hd) << 5); }
    if (n0 < 4608) return n0;
    if (n0 < 5632) { const int o = n0 - 4608; return (18 + (o >> 7)) * 256 + (o & 127); }
    if (n0 < 6656) { const int o = n0 - 5632; return (18 + (o >> 7)) * 256 + 128 + (o & 127); }
    return n0;
}
__device__ __forceinline__ void p0_transpose_item(const float* W, int K, int N, bf16* WT, bool remap, LAS float* scr, int item, int lane) {
    const int nblk = N / 32, kb = item / nblk, nb = item % nblk, k0 = 64 * kb, n0 = 32 * nb;
    const int d0 = remap ? win_dst_row(n0) : n0;
#pragma unroll 8
    for (int i = 0; i < 32; ++i) { const int kk = 2 * i + (lane >> 5); scr[kk * 33 + (lane & 31)] = W[(size_t)(k0 + kk) * N + n0 + (lane & 31)]; }
    asm volatile("s_waitcnt lgkmcnt(0)" ::: "memory");
    const int c = lane & 7;
#pragma unroll
    for (int j = 0; j < 4; ++j) { const int n = (lane >> 3) + 8 * j; const LAS float* s = scr + (8 * c) * 33 + n;
        v4u o; o.x = pkbf(s[0 * 33], s[1 * 33]); o.y = pkbf(s[2 * 33], s[3 * 33]); o.z = pkbf(s[4 * 33], s[5 * 33]); o.w = pkbf(s[6 * 33], s[7 * 33]);
        *(v4u*)(WT + (size_t)(d0 + n) * K + k0 + 8 * c) = o; }
    asm volatile("s_waitcnt lgkmcnt(0)" ::: "memory");
}
__device__ __forceinline__ void norm_row_bf16(const float* xrow, bf16* orow, const float* g, const float* sc, const float* sh, int lane) {
    const f32x4* xr = (const f32x4*)xrow + lane; f32x4 v[4]; float s = 0.f;
#pragma unroll
    for (int j = 0; j < 4; ++j) { v[j] = xr[64 * j]; s += (v[j].x * v[j].x + v[j].y * v[j].y) + (v[j].z * v[j].z + v[j].w * v[j].w); }
    const float rstd = 1.f / sqrtf(wave_sum(s) * (1.f / 1024.f) + EPS);
    unsigned long long* o8 = (unsigned long long*)orow + lane;
#pragma unroll
    for (int j = 0; j < 4; ++j) {
        const f32x4 gg = ((const f32x4*)g)[lane + 64 * j], cc = ((const f32x4*)sc)[lane + 64 * j], hh = ((const f32x4*)sh)[lane + 64 * j];
        const f32x4 y = v[j] * rstd * gg * (cc + 1.0f) + hh;
        o8[64 * j] = (unsigned long long)pkbf(y.x, y.y) | ((unsigned long long)pkbf(y.z, y.w) << 32);
    }
}
__device__ __forceinline__ void norm_row_f32(float* xrow, const float* g, int lane) {
    f32x4* xr = (f32x4*)xrow + lane; f32x4 v[4]; float s = 0.f;
#pragma unroll
    for (int j = 0; j < 4; ++j) { v[j] = xr[64 * j]; s += (v[j].x * v[j].x + v[j].y * v[j].y) + (v[j].z * v[j].z + v[j].w * v[j].w); }
    const float rstd = 1.f / sqrtf(wave_sum(s) * (1.f / 1024.f) + EPS);
#pragma unroll
    for (int j = 0; j < 4; ++j) { const f32x4 gg = ((const f32x4*)g)[lane + 64 * j]; xr[64 * j] = v[j] * rstd * gg; }
}

typedef short bf16x8_t __attribute__((ext_vector_type(8)));
typedef short s16x4_t __attribute__((ext_vector_type(4)));
typedef float f32x16_t __attribute__((ext_vector_type(16)));
constexpr int AT_V = 49152;
__device__ __forceinline__ int crow_(int r, int hi) { return (r & 3) + 8 * (r >> 2) + 4 * hi; }
__device__ __forceinline__ s16x4_t vtr_(LAS const unsigned char* p) { return __builtin_bit_cast(s16x4_t, __builtin_amdgcn_ds_read_tr16_b64_v4i16((LAS s16x4_t*)p)); }
__device__ __forceinline__ void attn_unit(LAS unsigned char* L, unsigned char* ws, int chunk, int u, int lane, int wave) {
    const int S = (chunk == 0) ? 4096 : 16384, upb = S >> 8;
    const int j = u % upb, bh = u / upb, head = bh % 24, b = bh / 24;
    const int dsh = 2 * (head >> 3), Ls = S >> dsh, nqb = Ls >> 8;
    const int rho = j / nqb, qb = j % nqb, l0 = qb << 8, rb = b * 4096 + rho;
    const bf16* Qh = (const bf16*)(ws + WS_Q) + head * 64; const bf16* Kh = (const bf16*)(ws + WS_K) + head * 64; const bf16* Vh = (const bf16*)(ws + WS_V) + head * 64;
    const int r32 = lane & 31, hi = lane >> 5;
    v4u kv[6], vv[6];
    const int g8 = lane >> 3, i8 = lane & 7;
    const int kkl = wave * 8 + i8, kch = g8;
    const int vkl = wave * 8 + 2 * (g8 >> 1) + (i8 >> 2), vch = 4 * (g8 & 1) + (i8 & 3);
#pragma unroll
    for (int p = 0; p < 6; ++p) {
        const int lk = l0 - 64 + p * 64 + kkl; kv[p] = (v4u){0u, 0u, 0u, 0u};
        if (lk >= 0 && lk < Ls) kv[p] = *(const v4u*)(Kh + (size_t)(rb + (lk << dsh)) * QW + kch * 8);
        const int lv = l0 - 64 + p * 64 + vkl; vv[p] = (v4u){0u, 0u, 0u, 0u};
        if (lv >= 0 && lv < Ls) vv[p] = *(const v4u*)(Vh + (size_t)(rb + (lv << dsh)) * QW + vch * 8);
    }
    const int lq = l0 + 32 * wave + r32; const size_t qrow = (size_t)(rb + (lq << dsh));
    bf16x8_t qr[4];
#pragma unroll
    for (int d0 = 0; d0 < 4; ++d0) qr[d0] = *(const bf16x8_t*)(Qh + qrow * QW + 16 * d0 + 8 * hi);
#pragma unroll
    for (int p = 0; p < 6; ++p) {
        *(LAS v4u*)(L + (kch * 384 + p * 64 + kkl) * 16) = kv[p];
        *(LAS v4u*)(L + AT_V + (vch >> 2) * 24576 + (p * 64 + vkl) * 64 + (vch & 3) * 16) = vv[p];
    }
    __syncthreads();
    f32x16_t p[5];
#pragma unroll
    for (int kb = 0; kb < 5; ++kb) {
        f32x16_t a = {0.f, 0.f, 0.f, 0.f, 0.f, 0.f, 0.f, 0.f, 0.f, 0.f, 0.f, 0.f, 0.f, 0.f, 0.f, 0.f};
#pragma unroll
        for (int d0 = 0; d0 < 4; ++d0) { const bf16x8_t kf = *(LAS const bf16x8_t*)(L + (2 * d0 + hi) * 6144 + (32 * wave + 32 * kb + r32) * 16);
            a = __builtin_amdgcn_mfma_f32_32x32x16_bf16(kf, qr[d0], a, 0, 0, 0); }
        p[kb] = a;
    }
#pragma unroll
    for (int r = 0; r < 16; ++r) { const int cr = crow_(r, hi); if (cr < r32) p[0][r] = -INFINITY; if (cr > r32) p[4][r] = -INFINITY; }
    const int kbase = l0 + 32 * wave - 64;
    if (kbase < 0 || kbase + 160 > Ls) {
#pragma unroll
        for (int kb = 0; kb < 5; ++kb)
#pragma unroll
            for (int r = 0; r < 16; ++r) { const int lk = kbase + 32 * kb + crow_(r, hi); if (lk < 0 || lk >= Ls) p[kb][r] = -INFINITY; }
    }
    float mx = -INFINITY;
#pragma unroll
    for (int kb = 0; kb < 5; ++kb)
#pragma unroll
        for (int r = 0; r < 16; ++r) mx = fmaxf(mx, p[kb][r]);
    mx = fmaxf(mx, __shfl_xor(mx, 32));
    float lsum = 0.f;
#pragma unroll
    for (int kb = 0; kb < 5; ++kb)
#pragma unroll
        for (int r = 0; r < 16; ++r) { const float e = __builtin_amdgcn_exp2f(p[kb][r] - mx); p[kb][r] = e; lsum += e; }
    lsum += __shfl_xor(lsum, 32);
    f32x16_t ot[2];
    ot[0] = (f32x16_t){0.f, 0.f, 0.f, 0.f, 0.f, 0.f, 0.f, 0.f, 0.f, 0.f, 0.f, 0.f, 0.f, 0.f, 0.f, 0.f}; ot[1] = ot[0];
    LAS const unsigned char* vbase = L + AT_V + ((lane >> 4) & 1) * 32 + (lane & 3) * 8 + (4 * hi + ((lane & 15) >> 2)) * 64 + (32 * wave) * 64;
#pragma unroll
    for (int kb = 0; kb < 5; ++kb)
#pragma unroll
        for (int ks = 0; ks < 2; ++ks) {
            v4u pw; pw.x = pkbf(p[kb][8 * ks + 0], p[kb][8 * ks + 1]); pw.y = pkbf(p[kb][8 * ks + 2], p[kb][8 * ks + 3]); pw.z = pkbf(p[kb][8 * ks + 4], p[kb][8 * ks + 5]); pw.w = pkbf(p[kb][8 * ks + 6], p[kb][8 * ks + 7]);
            const bf16x8_t pf = __builtin_bit_cast(bf16x8_t, pw);
#pragma unroll
            for (int c = 0; c < 2; ++c) {
                LAS const unsigned char* vp = vbase + c * 24576 + (32 * kb + 16 * ks) * 64;
                const s16x4_t lo4 = vtr_(vp), hi4 = vtr_(vp + 8 * 64);
                const bf16x8_t vf = (bf16x8_t){lo4[0], lo4[1], lo4[2], lo4[3], hi4[0], hi4[1], hi4[2], hi4[3]};
                ot[c] = __builtin_amdgcn_mfma_f32_32x32x16_bf16(vf, pf, ot[c], 0, 0, 0);
            }
        }
    const float inv = 1.f / lsum;
    bf16* Oh = (bf16*)(ws + WS_Q) + head * 64 + qrow * QW;
#pragma unroll
    for (int c = 0; c < 2; ++c)
#pragma unroll
        for (int r4 = 0; r4 < 4; ++r4) {
            v2u w; w.x = pkbf(ot[c][4 * r4 + 0] * inv, ot[c][4 * r4 + 1] * inv); w.y = pkbf(ot[c][4 * r4 + 2] * inv, ot[c][4 * r4 + 3] * inv);
            *(v2u*)(Oh + 32 * c + 8 * r4 + 4 * hi) = w;
        }
    if (hi == 0) ((float*)(ws + WS_LSE))[qrow * 24 + head] = mx + __builtin_amdgcn_logf(lsum);
    __syncthreads();
}

#define XB_TMO      128
#define XB_XCNT(j)  (256  + 64 * (j))
#define XB_XSUB(j)  (1280 + 64 * (j))
#define XB_XGEN(j)  (2304 + 64 * (j))
#define XB_TOP      3328
#define XB_TOPGEN   3392
#define XCD_BAR_WORDS 3456
#define XB_SPIN_CAP (1u << 18)

__device__ __forceinline__ unsigned xb_ld(unsigned* p)              { return __hip_atomic_load(p, __ATOMIC_RELAXED, __HIP_MEMORY_SCOPE_AGENT); }
__device__ __forceinline__ unsigned xb_add(unsigned* p, unsigned v) { return __hip_atomic_fetch_add(p, v, __ATOMIC_RELAXED, __HIP_MEMORY_SCOPE_AGENT); }
__device__ __forceinline__ unsigned xb_xcc_id() { return (unsigned)__builtin_amdgcn_s_getreg((3 << 11) | 20) & 0xFu; }
#define XB_SPIN(cond, bar) do { unsigned _sp = 0; while (cond) { __builtin_amdgcn_s_sleep(1); \
    if ((++_sp & 255u) == 0u) { if (xb_ld(&(bar)[XB_TMO])) break; if (_sp > XB_SPIN_CAP) { atomicAdd(&(bar)[XB_TMO], 1u); break; } } } } while (0)

struct XcdBarrier {
    unsigned* bar; unsigned x;
    volatile LAS unsigned* st;
};

__device__ __forceinline__ XcdBarrier xcd_barrier_post(unsigned* bar, volatile LAS unsigned* st) {
    XcdBarrier b; b.bar = bar; b.x = xb_xcc_id(); b.st = st;
    if (threadIdx.x == 0) (void)xb_add(&bar[XB_XCNT(b.x)], 1u);
    return b;
}
__device__ __forceinline__ void xcd_barrier_complete(unsigned* bar, unsigned x, unsigned& nloc, unsigned& nx) {
    const unsigned G = gridDim.x * gridDim.y * gridDim.z;
    unsigned sum, cnt, mine, sp = 0u;
    for (;;) {
        sum = 0u; cnt = 0u; mine = 0u;
#pragma unroll
        for (unsigned j = 0; j < 16; ++j) { const unsigned c = xb_ld(&bar[XB_XCNT(j)]); sum += c; cnt += (c > 0u) ? 1u : 0u; mine = (j == x) ? c : mine; }
        if (sum == G) break;
        __builtin_amdgcn_s_sleep(1);
        if ((++sp & 255u) == 0u) { if (xb_ld(&bar[XB_TMO])) break; if (sp > XB_SPIN_CAP) { atomicAdd(&bar[XB_TMO], 1u); break; } }
    }
    nloc = mine > 0u ? mine : 1u; nx = cnt > 0u ? cnt : 1u;
}

__device__ __forceinline__ void xcd_barrier(const XcdBarrier& b) {
    asm volatile("s_waitcnt vmcnt(0)" ::: "memory");
    __syncthreads();
    if (threadIdx.x == 0) {
        unsigned* bar = b.bar;
        __builtin_amdgcn_s_waitcnt(0);
        unsigned nloc = b.st[0], nx = b.st[1];
        if (nloc == 0u) { xcd_barrier_complete(bar, b.x, nloc, nx); b.st[0] = nloc; b.st[1] = nx; }
        const unsigned old = xb_add(&bar[XB_XSUB(b.x)], 1u);
        const unsigned gen = old / nloc;
        if (old + 1u == (gen + 1u) * nloc) {
            __builtin_amdgcn_fence(__ATOMIC_RELEASE, "agent");
            asm volatile("s_waitcnt vmcnt(0)" ::: "memory");
            const unsigned og = xb_add(&bar[XB_TOP], 1u);
            const unsigned tg = og / nx;
            if (og + 1u == (tg + 1u) * nx) xb_add(&bar[XB_TOPGEN], 1u);
            else XB_SPIN(xb_ld(&bar[XB_TOPGEN]) == tg, bar);
            __builtin_amdgcn_fence(__ATOMIC_ACQUIRE, "agent");
            xb_add(&bar[XB_XGEN(b.x)], 1u);
            asm volatile("s_waitcnt vmcnt(0)" ::: "memory");
        } else {
            XB_SPIN(xb_ld(&bar[XB_XGEN(b.x)]) == gen, bar);
            __builtin_amdgcn_fence(__ATOMIC_ACQUIRE, "agent");
            asm volatile("s_waitcnt vmcnt(0)" ::: "memory");
        }
    }
    __syncthreads();
}

constexpr int NPHASE = 2 + 8 * NCHUNK + 1;
typedef __attribute__((address_space(4))) const unsigned char kconst_t;
__device__ __forceinline__ const float* inptr(int i) { kconst_t* kp = (kconst_t*)__builtin_amdgcn_kernarg_segment_ptr(); asm volatile("" : "+s"(kp)); return *(const float* const __attribute__((address_space(4)))*)(kp + 8 * i); }
__device__ __forceinline__ int opq(int v) { asm volatile("" : "+s"(v)); return v; }
__device__ __forceinline__ unsigned char* wsptr() { kconst_t* kp = (kconst_t*)__builtin_amdgcn_kernarg_segment_ptr(); asm volatile("" : "+s"(kp)); return *(unsigned char* const __attribute__((address_space(4)))*)(kp + 8 * 18); }
__device__ __forceinline__ float* outptr() { kconst_t* kp = (kconst_t*)__builtin_amdgcn_kernarg_segment_ptr(); asm volatile("" : "+s"(kp)); return *(float* const __attribute__((address_space(4)))*)(kp + 8 * 17); }
__global__ void __launch_bounds__(NWAVES * 64, 2) mk_fwd(Args args) {
    extern __shared__ __attribute__((aligned(16))) unsigned char lds[];
    cg::grid_group grid = cg::this_grid();
    LAS unsigned char* L = (LAS unsigned char*)lds;
    const int tid = threadIdx.x, lane = tid & 63, wave = __builtin_amdgcn_readfirstlane(tid >> 6);
    const int G = gridDim.x, bx = blockIdx.x;
    const int gw = bx * NWAVES + wave, NGW = G * NWAVES;
    const int lo = args.ph_lo, hi = args.ph_hi;
    volatile LAS unsigned* MISC = (volatile LAS unsigned*)(L + 131072 + 320);
    if (tid < 32) MISC[tid] = 0u;
    __syncthreads();
    XcdBarrier bar = xcd_barrier_post((unsigned*)wsptr() + 4096, MISC + 8);
#define IN(k) (lo <= (k) && (k) < hi)
#ifndef PROBE_SYNC
#define PROBE_SYNC 1
#endif
#ifndef PROBE_P1
#define PROBE_P1 1
#endif
#ifndef PROBE_P4
#define PROBE_P4 1
#endif
#define SEAM(k) do { if (IN(k) && IN((k) + 1)) { if ((k) == 0) grid.sync(); else xcd_barrier(bar); } } while (0)

    if (IN(0)) {
        unsigned char* ws = wsptr();
        LAS float* scr = (LAS float*)(L + wave * 16384);
        constexpr int I_IN = 16 * (NIN / 32), I_AO = 8 * 32, I_CO = 16 * 32, I_MO = 16 * 32, I_MI = 16 * 128, I_MO2 = 64 * 32;
        constexpr int NITEMS = I_IN + I_AO + I_CO + I_MO + I_MI + I_MO2;
        for (int it = gw; it < NITEMS; it += NGW) {
            int r = it;
            if (r < I_IN) { p0_transpose_item(inptr(7), 1024, NIN, (bf16*)(ws + WS_WIN), true, scr, r, lane); continue; } r -= I_IN;
            if (r < I_AO) { p0_transpose_item(inptr(10), 512, 1024, (bf16*)(ws + WS_WAO), false, scr, r, lane); continue; } r -= I_AO;
            if (r < I_CO) { p0_transpose_item(inptr(11), 1024, 1024, (bf16*)(ws + WS_WCO), false, scr, r, lane); continue; } r -= I_CO;
            if (r < I_MO) { p0_transpose_item(inptr(12), 1024, 1024, (bf16*)(ws + WS_WMO), false, scr, r, lane); continue; } r -= I_MO;
            if (r < I_MI) { p0_transpose_item(inptr(14), 1024, 4096, (bf16*)(ws + WS_WMI), false, scr, r, lane); continue; } r -= I_MI;
            p0_transpose_item(inptr(15), 4096, 1024, (bf16*)(ws + WS_WMO2), false, scr, r, lane);
        }
        float* rope = (float*)(ws + WS_ROPE);
        for (int i = bx * 512 + tid; i < 16384 * 32; i += G * 512) {
            const int s = i >> 5, j = i & 31;
            const double inv = exp(-(double)j * (9.210340371976184 / 32.0));
            const double rev = (double)s * inv * 0.15915494309189535;
            const float fr = (float)(rev - rint(rev));
            float2 cs; cs.x = __builtin_amdgcn_cosf(fr); cs.y = __builtin_amdgcn_sinf(fr);
            ((float2*)rope)[i] = cs;
        }
        __syncthreads();
        LAS float* red = (LAS float*)L;
        const float *c_p = inptr(2), *c_s = inptr(3), *w_ada = inptr(4), *b_ada = inptr(5); float* mod = (float*)(ws + WS_MOD);
        for (int item = bx; item < 96; item += G) {
            const int e = item * 64 + lane; float a[NB];
#pragma unroll
            for (int b = 0; b < NB; ++b) a[b] = 0.f;
#pragma unroll 4
            for (int k = 128 * wave; k < 128 * wave + 128; ++k) {
                const float wv = w_ada[(size_t)k * 6144 + e];
#pragma unroll
                for (int b = 0; b < NB; ++b) { const float cv = (b < 4) ? c_p[b * 1024 + k] : c_s[(b - 4) * 1024 + k]; a[b] += (cv * sigmoidf_(cv)) * wv; }
            }
#pragma unroll
            for (int b = 0; b < NB; ++b) red[(wave * NB + b) * 64 + lane] = a[b];
            __syncthreads();
            if (wave < NB) { float t = b_ada[e];
#pragma unroll
                for (int w = 0; w < 8; ++w) t += red[(w * NB + wave) * 64 + lane];
                mod[wave * 6144 + e] = t; }
            __syncthreads();
        }
    }
    SEAM(0);
    if (IN(1)) {
        unsigned char* ws = wsptr(); float* out = outptr(); const float* mod = (const float*)(ws + WS_MOD);
        const float *x0 = inptr(0), *x1 = inptr(1), *g1 = inptr(6);
        for (int m = gw; m < MTOT; m += NGW) {
            const int chunk = m >> 14, r = m & (MC - 1); int bi, s, S; rowinfo(chunk, r, bi, s, S);
            const float* xrow = (m < MC) ? x0 + (size_t)m * DM : x1 + (size_t)(m - MC) * DM;
            bf16* xn = (bf16*)(out + (size_t)chunk * MC * DM) + (size_t)r * DM;
            norm_row_bf16(xrow, xn, g1, mod + bi * 6144 + 1024, mod + bi * 6144, lane);
        }
    }
    SEAM(1);
#pragma nounroll
    for (int chunk = 0; chunk < NCHUNK; ++chunk) {
        const int pb = 2 + 8 * chunk;
        if (IN(pb + 0)) {
            unsigned char* ws = wsptr(); float* outc = outptr() + (size_t)chunk * MC * DM;
            pg8::Gemm g{(const pg8::bf16_t*)outc, (const bf16*)(ws + WS_WIN), MC, NIN, DM}; pg8::StaticOrder S; S.init(MC, NIN, opq(G), opq(bx));
            pg8::EpiIn E{chunk, ws};
            for (int q_ = 0; q_ < PROBE_P1; ++q_) pg8::gemm_phase<pg8::EpiIn, pg8::StaticOrder, true, true>(L, g, S, E);
        }
        SEAM(pb + 0);
        if (IN(pb + 1)) {
            unsigned char* ws = wsptr(); int tid_o = tid, lane_o = lane, gw_o = gw; asm volatile("" : "+v"(tid_o), "+v"(lane_o), "+s"(gw_o));
            const bf16 *Ub = (const bf16*)(ws + WS_U), *BGb = (const bf16*)(ws + WS_BG); bf16* CVb = (bf16*)(ws + WS_CVIN);
            const float *conv_w = inptr(8), *conv_b = inptr(9);
            for (int i = bx * 512 + tid_o; i < MC * 128; i += G * 512) {
                const int r = i >> 7, c8 = (i & 127) * 8; int bi, s, S; rowinfo(chunk, r, bi, s, S);
                const v4u uc = *(const v4u*)(Ub + (size_t)r * 1024 + c8);
                v4u up = {0u, 0u, 0u, 0u}, un = {0u, 0u, 0u, 0u};
                if (s > 0) up = *(const v4u*)(Ub + (size_t)(r - 1) * 1024 + c8);
                if (s < S - 1) un = *(const v4u*)(Ub + (size_t)(r + 1) * 1024 + c8);
                const v4u bg = *(const v4u*)(BGb + (size_t)r * 1024 + c8);
                const f32x4 w0a = *(const f32x4*)(conv_w + c8), w0b = *(const f32x4*)(conv_w + c8 + 4);
                const f32x4 w1a = *(const f32x4*)(conv_w + 1024 + c8), w1b = *(const f32x4*)(conv_w + 1024 + c8 + 4);
                const f32x4 w2a = *(const f32x4*)(conv_w + 2048 + c8), w2b = *(const f32x4*)(conv_w + 2048 + c8 + 4);
                const f32x4 cba = *(const f32x4*)(conv_b + c8), cbb = *(const f32x4*)(conv_b + c8 + 4);
                float y[8];
#define CV1(e, UP, UC, UN, BGV, W0, W1, W2, CB) y[e] = (BGV) * ((CB) + (UP) * (W0) + (UC) * (W1) + (UN) * (W2))
                CV1(0, bflo(up.x), bflo(uc.x), bflo(un.x), bflo(bg.x), w0a[0], w1a[0], w2a[0], cba[0]);
                CV1(1, bfhi(up.x), bfhi(uc.x), bfhi(un.x), bfhi(bg.x), w0a[1], w1a[1], w2a[1], cba[1]);
                CV1(2, bflo(up.y), bflo(uc.y), bflo(un.y), bflo(bg.y), w0a[2], w1a[2], w2a[2], cba[2]);
                CV1(3, bfhi(up.y), bfhi(uc.y), bfhi(un.y), bfhi(bg.y), w0a[3], w1a[3], w2a[3], cba[3]);
                CV1(4, bflo(up.z), bflo(uc.z), bflo(un.z), bflo(bg.z), w0b[0], w1b[0], w2b[0], cbb[0]);
                CV1(5, bfhi(up.z), bfhi(uc.z), bfhi(un.z), bfhi(bg.z), w0b[1], w1b[1], w2b[1], cbb[1]);
                CV1(6, bflo(up.w), bflo(uc.w), bflo(un.w), bflo(bg.w), w0b[2], w1b[2], w2b[2], cbb[2]);
                CV1(7, bfhi(up.w), bfhi(uc.w), bfhi(un.w), bfhi(bg.w), w0b[3], w1b[3], w2b[3], cbb[3]);
#undef CV1
                v4u o; o.x = pkbf(y[0], y[1]); o.y = pkbf(y[2], y[3]); o.z = pkbf(y[4], y[5]); o.w = pkbf(y[6], y[7]);
                *(v4u*)(CVb + (size_t)r * 1024 + c8) = o;
            }
            __syncthreads();
            for (int u = opq(bx); u < 1536; u += G) attn_unit(L, ws, chunk, u, lane_o, wave);
        }
        SEAM(pb + 1);
        if (IN(pb + 2)) {
            unsigned char* ws = wsptr(); int tid_o = tid; asm volatile("" : "+v"(tid_o));
            const float* LSE = (const float*)(ws + WS_LSE); const bf16* Ob = (const bf16*)(ws + WS_Q); bf16* ATTb = (bf16*)(ws + WS_ATT);
            for (int i = bx * 512 + tid_o; i < MC * 64; i += G * 512) {
                const int row = i >> 6, hh = (i >> 3) & 7, c8 = i & 7;
                const float l0 = LSE[row * 24 + hh], l1 = LSE[row * 24 + 8 + hh], l2 = LSE[row * 24 + 16 + hh];
                const float mx = fmaxf(l0, fmaxf(l1, l2));
                float w0 = __builtin_amdgcn_exp2f(l0 - mx), w1 = __builtin_amdgcn_exp2f(l1 - mx), w2 = __builtin_amdgcn_exp2f(l2 - mx);
                const float inv = 1.f / (w0 + w1 + w2); w0 *= inv; w1 *= inv; w2 *= inv;
                const bf16* op = Ob + (size_t)row * QW + hh * 64 + c8 * 8;
                const v4u a = *(const v4u*)op, bq = *(const v4u*)(op + 512), c = *(const v4u*)(op + 1024);
                v4u o;
                o.x = pkbf(w0 * bflo(a.x) + w1 * bflo(bq.x) + w2 * bflo(c.x), w0 * bfhi(a.x) + w1 * bfhi(bq.x) + w2 * bfhi(c.x));
                o.y = pkbf(w0 * bflo(a.y) + w1 * bflo(bq.y) + w2 * bflo(c.y), w0 * bfhi(a.y) + w1 * bfhi(bq.y) + w2 * bfhi(c.y));
                o.z = pkbf(w0 * bflo(a.z) + w1 * bflo(bq.z) + w2 * bflo(c.z), w0 * bfhi(a.z) + w1 * bfhi(bq.z) + w2 * bfhi(c.z));
                o.w = pkbf(w0 * bflo(a.w) + w1 * bflo(bq.w) + w2 * bflo(c.w), w0 * bfhi(a.w) + w1 * bfhi(bq.w) + w2 * bfhi(c.w));
                *(v4u*)(ATTb + (size_t)row * ATTO + hh * 64 + c8 * 8) = o;
            }
            pg8::Gemm g{(const bf16*)(ws + WS_CVIN), (const bf16*)(ws + WS_WCO), MC, DM, DM}; pg8::StaticOrder S; S.init(MC, DM, opq(G), opq(bx));
            pg8::EpiGate<0> E{(bf16*)(ws + WS_T1), (const bf16*)(ws + WS_GC), nullptr, 1024};
            pg8::gemm_phase<pg8::EpiGate<0>, pg8::StaticOrder, true, true>(L, g, S, E);
        }
        SEAM(pb + 2);
        if (IN(pb + 3)) {
            unsigned char* ws = wsptr();
            pg8::Gemm g{(const bf16*)(ws + WS_ATT), (const bf16*)(ws + WS_WAO), MC, DM, ATTO}; pg8::StaticOrder S; S.init(MC, DM, opq(G), opq(bx));
            pg8::EpiGate<1> E{(bf16*)(ws + WS_MRG), (const bf16*)(ws + WS_GA), (const bf16*)(ws + WS_T1), 1024};
            pg8::gemm_phase<pg8::EpiGate<1>, pg8::StaticOrder, true, true>(L, g, S, E);
        }
        SEAM(pb + 3);
        if (IN(pb + 4)) {
            unsigned char* ws = wsptr(); float* outc = outptr() + (size_t)chunk * MC * DM;
            const float* xc = (chunk == 0) ? inptr(0) : inptr(1) + (size_t)(chunk - 1) * MC * DM;
            pg8::Gemm g{(const bf16*)(ws + WS_MRG), (const bf16*)(ws + WS_WMO), MC, DM, DM}; pg8::StaticOrder S; S.init(MC, DM, opq(G), opq(bx));
            pg8::EpiRes E{xc, outc, (const float*)(ws + WS_MOD) + 2048, chunk};
            pg8::gemm_phase<pg8::EpiRes, pg8::StaticOrder, true, true>(L, g, S, E);
        }
        SEAM(pb + 4);
        if (IN(pb + 5)) {
            int lane_o = lane, gw_o = gw; asm volatile("" : "+v"(lane_o), "+s"(gw_o));
            unsigned char* ws = wsptr(); float* outc = outptr() + (size_t)chunk * MC * DM; const float* mod = (const float*)(ws + WS_MOD); const float* g2 = inptr(13);
            bf16* XN2b = (bf16*)(ws + WS_XN2);
            for (int r = gw_o; r < MC; r += NGW) { int bi, s, S; rowinfo(chunk, r, bi, s, S);
                norm_row_bf16(outc + (size_t)r * DM, XN2b + (size_t)r * DM, g2, mod + bi * 6144 + 4096, mod + bi * 6144 + 3072, lane_o); }
        }
        SEAM(pb + 5);
        if (IN(pb + 6)) {
            unsigned char* ws = wsptr();
            pg8::Gemm g{(const bf16*)(ws + WS_XN2), (const bf16*)(ws + WS_WMI), MC, DFF, DM}; pg8::StaticOrder S; S.init(MC, DFF, opq(G), opq(bx));
            pg8::EpiGate<2> E{(bf16*)(ws + WS_HDN), nullptr, nullptr, DFF};
            for (int q_ = 0; q_ < PROBE_P4; ++q_) pg8::gemm_phase<pg8::EpiGate<2>, pg8::StaticOrder, true, true>(L, g, S, E);
        }
        SEAM(pb + 6);
        if (IN(pb + 7)) {
            unsigned char* ws = wsptr(); float* outc = outptr() + (size_t)chunk * MC * DM;
            pg8::Gemm g{(const bf16*)(ws + WS_HDN), (const bf16*)(ws + WS_WMO2), MC, DM, DFF}; pg8::StaticOrder S; S.init(MC, DM, opq(G), opq(bx));
            pg8::EpiRes E{outc, outc, (const float*)(ws + WS_MOD) + 5120, chunk};
            pg8::gemm_phase<pg8::EpiRes, pg8::StaticOrder, true, true>(L, g, S, E);
        }
        SEAM(pb + 7);
    }
    if (IN(NPHASE - 1)) {
        float* out = outptr(); const float* gf = inptr(16);
        for (int m = gw; m < MTOT; m += NGW) norm_row_f32(out + (size_t)m * DM, gf, lane);
    }
#undef IN
#undef SEAM
}

#ifndef MK_N_LAUNCHES
#define MK_N_LAUNCHES 1
#endif
extern "C" void kernel_launch(void* const* d_in, const int* in_sizes, int n_in, void* d_out, int out_size, void* d_ws, size_t ws_size, hipStream_t stream) {
    static int grid = 0;
    if (grid == 0) {
        if (n_in != 17 || out_size != MTOT * DM || ws_size < WS_END) { fprintf(stderr, "kernel_launch: unexpected shapes (n_in %d out %d ws %zu)\n", n_in, out_size, ws_size); grid = -1; return; }
        int dev = 0, cus = 0, per_cu = 0;
        if (hipGetDevice(&dev) != hipSuccess || hipDeviceGetAttribute(&cus, hipDeviceAttributeMultiprocessorCount, dev) != hipSuccess) { grid = -1; return; }
        if (hipFuncSetAttribute((const void*)mk_fwd, hipFuncAttributeMaxDynamicSharedMemorySize, LDS_BYTES) != hipSuccess) { fprintf(stderr, "kernel_launch: hipFuncSetAttribute failed\n"); grid = -1; return; }
        if (hipOccupancyMaxActiveBlocksPerMultiprocessor(&per_cu, (const void*)mk_fwd, NWAVES * 64, LDS_BYTES) != hipSuccess || per_cu < 1) { fprintf(stderr, "kernel_launch: occupancy query says %d\n", per_cu); (void)hipGetLastError(); per_cu = 1; }
        if (per_cu > 1) per_cu = 1;
        grid = cus * per_cu;
    }
    if (grid < 0) return;
    Args a{};
    for (int i = 0; i < 17; ++i) a.in[i] = (const float*)d_in[i];
    a.out = (float*)d_out; a.ws = (unsigned char*)d_ws;
    if (hipMemsetAsync(d_ws, 0, 65536, stream) != hipSuccess) { fprintf(stderr, "kernel_launch: memset failed\n"); return; }
    if (MK_N_LAUNCHES == 1) {
        a.ph_lo = 0; a.ph_hi = NPHASE;
        void* kargs[] = {&a};
        hipError_t e = hipLaunchCooperativeKernel((const void*)mk_fwd, dim3(grid), dim3(NWAVES * 64), kargs, LDS_BYTES, stream);
        if (e != hipSuccess) fprintf(stderr, "cooperative launch failed: %s (grid %d)\n", hipGetErrorString(e), grid);
    } else {
        for (int p = 0; p < NPHASE; ++p) { a.ph_lo = p; a.ph_hi = p + 1; hipLaunchKernelGGL(mk_fwd, dim3(grid), dim3(NWAVES * 64), LDS_BYTES, stream, a); }
    }
}
```
